# Optimizing an MI355X kernel written in HIP

```python
import jax, jax.numpy as jnp
from jax import lax
import numpy as np

D_MODEL = 1024
BATCH = 8
SEQ = 2048
DEPTH = 1

D_FF = 2816
POOL_WIDTH = D_MODEL // 2
POOL_WINDOWS = (2, 4, 8, 16)
N_POOL_GROUPS = len(POOL_WINDOWS)
POOL_GROUP = POOL_WIDTH // N_POOL_GROUPS
N_SB_HEADS = 8
SB_HEAD_DIM = 64
SB_WIDTH = N_SB_HEADS * SB_HEAD_DIM
Q_BLOCK = 128
IN_WIDTH = POOL_WIDTH + 3 * SB_WIDTH + 2 * D_MODEL
RMS_EPS = 1e-6

kernel_name = "macaron_pool_stickbreaking_gated_hybrid"


def rmsnorm(x, g):
    xf = x.astype(jnp.float32)
    r = lax.rsqrt(jnp.mean(xf * xf, axis=-1, keepdims=True) + RMS_EPS)
    return (xf * r * g.astype(jnp.float32)).astype(x.dtype)


def swiglu(x, w_gate_up, w_down):
    gu = x @ w_gate_up
    g, u = jnp.split(gu, 2, axis=-1)
    return (jax.nn.silu(g) * u) @ w_down


def causal_pool_mixer(xp, w_group, pool_scale):
    b, s, _ = xp.shape
    xg = xp.reshape(b, s, N_POOL_GROUPS, POOL_GROUP)
    pos = jnp.arange(s, dtype=jnp.int32)
    outs = []
    for gi, w in enumerate(POOL_WINDOWS):
        xi = xg[:, :, gi, :].astype(jnp.float32)
        cs = jnp.cumsum(xi, axis=1)
        lower = jnp.concatenate([jnp.zeros((b, w, POOL_GROUP), cs.dtype), cs[:, : s - w]], axis=1)
        count = jnp.minimum(pos + 1, w).astype(jnp.float32)[None, :, None]
        mean = (cs - lower) / count
        outs.append((mean - xi).astype(xp.dtype))
    y = jnp.stack(outs, axis=2)
    y = jnp.einsum('bsgc,gcd->bsgd', y, w_group)
    return y.reshape(b, s, POOL_WIDTH) * pool_scale


def stick_breaking_attention(q, k, v):
    s_len = q.shape[2]
    scale = 1.0 / np.sqrt(SB_HEAD_DIM)
    outs = []
    for blk in range(s_len // Q_BLOCK):
        i0, i1 = blk * Q_BLOCK, (blk + 1) * Q_BLOCK
        qb = q[:, :, i0:i1]
        kb = k[:, :, :i1]
        vb = v[:, :, :i1]
        z = jnp.einsum('bhqd,bhkd->bhqk', qb, kb).astype(jnp.float32) * scale
        qpos = jnp.arange(i0, i1)[:, None]
        kpos = jnp.arange(i1)[None, :]
        mask = kpos < qpos
        log_beta = jax.nn.log_sigmoid(z)
        log_1m_beta = jnp.where(mask, jax.nn.log_sigmoid(-z), 0.0)
        log_a = log_beta + lax.cumsum(log_1m_beta, axis=3, reverse=True) - log_1m_beta
        a = jnp.where(mask, jnp.exp(log_a), 0.0)
        outs.append(jnp.einsum('bhqk,bhkd->bhqd', a.astype(vb.dtype), vb))
    return jnp.concatenate(outs, axis=2)


def gated_mixer_block(u, w_in, pool_w_group, pool_scale, w_branch_pool, w_branch_attn, w_out):
    b, s, _ = u.shape
    proj = u @ w_in
    o1 = POOL_WIDTH
    o2 = o1 + SB_WIDTH
    o3 = o2 + SB_WIDTH
    o4 = o3 + SB_WIDTH
    xp = proj[..., :o1]
    q = proj[..., o1:o2].reshape(b, s, N_SB_HEADS, SB_HEAD_DIM).transpose(0, 2, 1, 3)
    k = proj[..., o2:o3].reshape(b, s, N_SB_HEADS, SB_HEAD_DIM).transpose(0, 2, 1, 3)
    v = proj[..., o3:o4].reshape(b, s, N_SB_HEADS, SB_HEAD_DIM).transpose(0, 2, 1, 3)
    gate_logits = proj[..., o4:]
    y_pool = causal_pool_mixer(xp, pool_w_group, pool_scale) @ w_branch_pool
    o_sb = stick_breaking_attention(q, k, v).transpose(0, 2, 1, 3).reshape(b, s, SB_WIDTH)
    y_sb = o_sb @ w_branch_attn
    g = jax.nn.sigmoid(gate_logits.astype(jnp.float32)).astype(u.dtype)
    g_pool, g_sb = jnp.split(g, 2, axis=-1)
    return (g_pool * y_pool + g_sb * y_sb) @ w_out


def setup_inputs(seed: int = 0) -> dict:
    key = jax.random.key(seed)
    ks = jax.random.split(key, 20)
    f32 = jnp.float32

    def w(k, shape, fan_in):
        return jax.random.normal(k, shape, f32) * (fan_in ** -0.5)

    def gain(k, shape):
        return 1.0 + 0.05 * jax.random.normal(k, shape, f32)

    L = DEPTH
    return {
        "x": jax.random.normal(ks[0], (BATCH, SEQ, D_MODEL), f32),
        "ffn1_norm": gain(ks[1], (L, D_MODEL)),
        "ffn1_w_gate_up": w(ks[2], (L, D_MODEL, 2 * D_FF), D_MODEL),
        "ffn1_w_down": w(ks[3], (L, D_FF, D_MODEL), D_FF),
        "mix_norm": gain(ks[4], (L, D_MODEL)),
        "w_in": w(ks[5], (L, D_MODEL, IN_WIDTH), D_MODEL),
        "pool_w_group": w(ks[6], (L, N_POOL_GROUPS, POOL_GROUP, POOL_GROUP), POOL_GROUP),
        "pool_scale": gain(ks[7], (L, POOL_WIDTH)),
        "w_branch_pool": w(ks[8], (L, POOL_WIDTH, D_MODEL), POOL_WIDTH),
        "w_branch_attn": w(ks[9], (L, SB_WIDTH, D_MODEL), SB_WIDTH),
        "w_out": w(ks[10], (L, D_MODEL, D_MODEL), D_MODEL),
        "ffn2_norm": gain(ks[11], (L, D_MODEL)),
        "ffn2_w_gate_up": w(ks[12], (L, D_MODEL, 2 * D_FF), D_MODEL),
        "ffn2_w_down": w(ks[13], (L, D_FF, D_MODEL), D_FF),
        "final_norm": gain(ks[14], (D_MODEL,)),
    }


def reference(x, ffn1_norm, ffn1_w_gate_up, ffn1_w_down, mix_norm, w_in, pool_w_group,
              pool_scale, w_branch_pool, w_branch_attn, w_out, ffn2_norm, ffn2_w_gate_up,
              ffn2_w_down, final_norm):
    h = x
    for l in range(DEPTH):
        h = h + 0.5 * swiglu(rmsnorm(h, ffn1_norm[l]), ffn1_w_gate_up[l], ffn1_w_down[l])
        u = rmsnorm(h, mix_norm[l])
        h = h + gated_mixer_block(u, w_in[l], pool_w_group[l], pool_scale[l],
                                  w_branch_pool[l], w_branch_attn[l], w_out[l])
        h = h + 0.5 * swiglu(rmsnorm(h, ffn2_norm[l]), ffn2_w_gate_up[l], ffn2_w_down[l])
    return rmsnorm(h, final_norm)
```

```cpp
#include <hip/hip_runtime.h>
#include <hip/hip_cooperative_groups.h>
#include <cstdio>
#include <cstdint>
namespace cg = cooperative_groups;
#ifndef DEBUG_MODE
#define DEBUG_MODE 0
#endif
namespace pg8 {
#define PG8_LAS __attribute__((address_space(3)))
typedef unsigned short bf16_t;
typedef short bf16x8 __attribute__((ext_vector_type(8)));
typedef float f32x4 __attribute__((ext_vector_type(4)));
typedef unsigned u32x4 __attribute__((ext_vector_type(4)));
constexpr int BM = 256, BK = 64, HALF = 128, HTB = HALF * BK * 2  , STAGE_BYTES = 8 * HTB, NXCD = 8, WGM = 8;

__host__ __device__ __forceinline__ int lds_byte(int r, int c) { const int st = (r >> 4) * 2 + (c >> 5), rr = r & 15, cc = c & 31, ob = rr * 64 + cc * 2; return st * 1024 + (ob ^ (((ob >> 9) & 1) << 5)); }
__host__ __device__ __forceinline__ void stage_rc(int b, int& R, int& C) { const int st = b / 1024, sb = b % 1024, swz = sb ^ (((sb >> 9) & 1) << 5); R = (st >> 1) * 16 + swz / 64; C = (st & 1) * 32 + (swz % 64) / 2; }
__host__ __device__ __forceinline__ int perm32(int rho) { const int n = rho >> 4, i = rho & 15; return 8 * (i >> 2) + 4 * n + (i & 3); }

struct Unit { int pm, pn; };
struct Gemm { const bf16_t* A; const bf16_t* Bt; int M, N, K; };

struct StaticOrder {
    int nM, nN, nwg, G, c;
    __host__ __device__ void init(int M, int N, int G_, int c_) { nM = M / BM; nN = N / BM; nwg = nM * nN; G = G_; c = c_; }
    __host__ __device__ bool next(int i, Unit& u) const {
        const long L = (long)i * G + c; if (L >= nwg) return false;
        int wgid = (int)L; { const int q = nwg / NXCD, r = nwg % NXCD, xcd = wgid % NXCD, off = wgid / NXCD; wgid = (xcd < r ? xcd * (q + 1) : r * (q + 1) + (xcd - r) * q) + off; }
        const int nig = WGM * nN, gid = wgid / nig, fm = gid * WGM, gsz = (nM - fm) < WGM ? (nM - fm) : WGM;
        u.pm = fm + ((wgid % nig) % gsz); u.pn = (wgid % nig) / gsz; return true;
    }
    __device__ __forceinline__ void a_ready(const Unit&) const {}
    __device__ __forceinline__ void done(const Unit&) const {}
};

__device__ __forceinline__ unsigned cvt_pk_bf16(float lo, float hi) { unsigned r; asm volatile("v_cvt_pk_bf16_f32 %0, %1, %2" : "=v"(r) : "v"(lo), "v"(hi)); return r; }
typedef float f32x2 __attribute__((ext_vector_type(2)));
constexpr float RMS_EPS_F = 1e-6f, LOG2E_F = 1.4426950408889634f;
__device__ __forceinline__ float row_rs(const float* ssq, int row) {
    const f32x4* p = (const f32x4*)(ssq + (size_t)row * 16);
    const f32x4 a = p[0], b = p[1], c = p[2], d = p[3];
    const float s = (((a[0] + a[1]) + (a[2] + a[3])) + ((b[0] + b[1]) + (b[2] + b[3]))) + (((c[0] + c[1]) + (c[2] + c[3])) + ((d[0] + d[1]) + (d[2] + d[3])));
    return __builtin_amdgcn_rsqf(s * (1.0f / 1024.0f) + RMS_EPS_F);
}
__device__ __forceinline__ void rows_rs(const float* ssq, int row0, int fq, float (&rs)[2][4]) {
    f32x4 q[2][4];
#pragma unroll
    for (int ai = 0; ai < 2; ++ai)
#pragma unroll
        for (int m = 0; m < 4; ++m) q[ai][m] = *(const f32x4*)(ssq + (size_t)(row0 + ai * HALF + m * 16) * 16 + 4 * fq);
#pragma unroll
    for (int ai = 0; ai < 2; ++ai)
#pragma unroll
        for (int m = 0; m < 4; ++m) { float s = (q[ai][m][0] + q[ai][m][1]) + (q[ai][m][2] + q[ai][m][3]); s += __shfl_xor(s, 16); s += __shfl_xor(s, 32); rs[ai][m] = __builtin_amdgcn_rsqf(s * (1.0f / 1024.0f) + RMS_EPS_F); }
}
__device__ __forceinline__ void unit_rs(const float* ssq, const PG8_LAS float* rsl, int pm0, const Unit& u, int wr, int fr, int fq, float (&rs)[2][4]) {
    if (u.pm == pm0) {
#pragma unroll
        for (int ai = 0; ai < 2; ++ai)
#pragma unroll
            for (int m = 0; m < 4; ++m) rs[ai][m] = rsl[ai * HALF + wr * 64 + m * 16 + fr];
    } else rows_rs(ssq, u.pm * BM + wr * 64 + fr, fq, rs);
}
__device__ __forceinline__ void load_panel_rs(const float* ssq, PG8_LAS float* rsl, int pm0) {
    const int t = threadIdx.x;
    if (t < 256) rsl[t] = row_rs(ssq, pm0 * BM + t);
    __syncthreads();
}
__device__ __forceinline__ float sigmoid_f(float v) { return __builtin_amdgcn_rcpf(1.0f + __builtin_amdgcn_exp2f(-v * LOG2E_F)); }
__device__ __forceinline__ float bflo(unsigned w) { return __builtin_bit_cast(float, w << 16); }
__device__ __forceinline__ float bfhi(unsigned w) { return __builtin_bit_cast(float, w & 0xffff0000u); }

struct EpiSwiGLU {
    static constexpr bool PERM = true, AFTER_DRAIN = false, MID = false;
    bf16_t* O; const float* ssq; int ldo; const PG8_LAS float* rsl; int pm0;
    __device__ __forceinline__ void operator()(const f32x4 (&acc)[2][2][4][2], const Unit& u, int wr, int wc, int fr, int fq) const {
        const int row0 = u.pm * BM + wr * 64 + fr, col0 = u.pn * HALF + wc * 32 + 8 * fq;
        float rsv[2][4] = {{1.f, 1.f, 1.f, 1.f}, {1.f, 1.f, 1.f, 1.f}};
        if (ssq) unit_rs(ssq, rsl, pm0, u, wr, fr, fq, rsv);
#pragma unroll
        for (int ai = 0; ai < 2; ++ai)
#pragma unroll
            for (int m = 0; m < 4; ++m) {
                const int row = row0 + ai * HALF + m * 16;
                const float rs = rsv[ai][m];
                float o[8];
                const float nrl = -rs * LOG2E_F, rs2 = rs * rs;
#pragma unroll
                for (int n = 0; n < 2; ++n)
#pragma unroll
                    for (int h = 0; h < 2; ++h) {
                        const f32x2 g = {acc[ai][0][m][n][2 * h], acc[ai][0][m][n][2 * h + 1]}, uu = {acc[ai][1][m][n][2 * h], acc[ai][1][m][n][2 * h + 1]};
                        const f32x2 t = g * nrl; f32x2 ex; ex.x = __builtin_amdgcn_exp2f(t.x); ex.y = __builtin_amdgcn_exp2f(t.y);
                        const f32x2 d = ex + 1.0f; f32x2 r; r.x = __builtin_amdgcn_rcpf(d.x); r.y = __builtin_amdgcn_rcpf(d.y);
                        const f32x2 p = ((g * uu) * rs2) * r;
                        o[4 * n + 2 * h] = p.x; o[4 * n + 2 * h + 1] = p.y;
                    }
                u32x4 w; w.x = cvt_pk_bf16(o[0], o[1]); w.y = cvt_pk_bf16(o[2], o[3]); w.z = cvt_pk_bf16(o[4], o[5]); w.w = cvt_pk_bf16(o[6], o[7]);
                *(u32x4*)(O + (size_t)row * ldo + col0) = w;
            }
    }
};
template <bool F32BASE> struct EpiDown {
    static constexpr bool PERM = true, AFTER_DRAIN = false, MID = false;
    const float* basef; const bf16_t* baseh; bf16_t* HB; float* ssq; float alpha;
    __device__ __forceinline__ void operator()(const f32x4 (&acc)[2][2][4][2], const Unit& u, int wr, int wc, int fr, int fq) const {
        const int row0 = u.pm * BM + wr * 64 + fr, col0 = u.pn * BM + wc * 32 + 8 * fq;
        u32x4 bh[F32BASE ? 1 : 2][4][2];
        if constexpr (!F32BASE) {
#pragma unroll
            for (int ai = 0; ai < 2; ++ai)
#pragma unroll
                for (int m = 0; m < 4; ++m)
#pragma unroll
                    for (int bj = 0; bj < 2; ++bj) bh[ai][m][bj] = *(const u32x4*)(baseh + (size_t)(row0 + ai * HALF + m * 16) * 1024 + col0 + bj * HALF);
        }
#pragma unroll
        for (int ai = 0; ai < 2; ++ai) {
            f32x4 bf[F32BASE ? 4 : 1][2][2];
            if constexpr (F32BASE) {
#pragma unroll
                for (int m = 0; m < 4; ++m)
#pragma unroll
                    for (int bj = 0; bj < 2; ++bj) { const size_t off = (size_t)(row0 + ai * HALF + m * 16) * 1024 + col0 + bj * HALF;
                        bf[m][bj][0] = *(const f32x4*)(basef + off); bf[m][bj][1] = *(const f32x4*)(basef + off + 4); }
            }
#pragma unroll
            for (int m = 0; m < 4; ++m) {
                const int row = row0 + ai * HALF + m * 16; float s = 0.f;
#pragma unroll
                for (int bj = 0; bj < 2; ++bj) {
                    const size_t off = (size_t)row * 1024 + col0 + bj * HALF;
                    f32x4 b0, b1;
                    if constexpr (F32BASE) { b0 = bf[m][bj][0]; b1 = bf[m][bj][1]; }
                    else { const u32x4 bw = bh[ai][m][bj]; b0 = (f32x4){bflo(bw.x), bfhi(bw.x), bflo(bw.y), bfhi(bw.y)}; b1 = (f32x4){bflo(bw.z), bfhi(bw.z), bflo(bw.w), bfhi(bw.w)}; }
                    const f32x4 h0 = b0 + acc[ai][bj][m][0] * alpha, h1 = b1 + acc[ai][bj][m][1] * alpha;
                    u32x4 w; w.x = cvt_pk_bf16(h0[0], h0[1]); w.y = cvt_pk_bf16(h0[2], h0[3]); w.z = cvt_pk_bf16(h1[0], h1[1]); w.w = cvt_pk_bf16(h1[2], h1[3]); *(u32x4*)(HB + off) = w;
                    s += ((h0[0] * h0[0] + h0[1] * h0[1]) + (h0[2] * h0[2] + h0[3] * h0[3])) + ((h1[0] * h1[0] + h1[1] * h1[1]) + (h1[2] * h1[2] + h1[3] * h1[3]));
                }
                s += __shfl_xor(s, 16); s += __shfl_xor(s, 32); if (fq == 0) ssq[(size_t)row * 16 + u.pn * 4 + wc] = s;
            }
        }
    }
};
struct EpiWin {
    static constexpr bool PERM = true, AFTER_DRAIN = false, MID = false;
    bf16_t* P4; bf16_t* GR; bf16_t* GS; const float* ssq; const PG8_LAS float* rsl; int pm0;
    __device__ __forceinline__ void operator()(const f32x4 (&acc)[2][2][4][2], const Unit& u, int wr, int wc, int fr, int fq) const {
        const int pn = u.pn; const bool gate = pn >= 8;
        const int row0 = u.pm * BM + wr * 64 + fr;
        float rsv[2][4]; unit_rs(ssq, rsl, pm0, u, wr, fr, fq, rsv);
        if (!gate) {
            bf16_t* basep = P4 + (size_t)(pn >> 1) * ((size_t)16384 * 512);
            const float qs = ((pn >> 1) == 1) ? 0.125f * LOG2E_F : 1.0f;
            const int col0 = (pn & 1) * 256 + wc * 32 + 8 * fq;
#pragma unroll
            for (int ai = 0; ai < 2; ++ai)
#pragma unroll
                for (int m = 0; m < 4; ++m) {
                    const int row = row0 + ai * HALF + m * 16;
                    const float rs = rsv[ai][m] * qs;
#pragma unroll
                    for (int bj = 0; bj < 2; ++bj) {
                        const f32x4 v0 = acc[ai][bj][m][0] * rs, v1 = acc[ai][bj][m][1] * rs;
                        u32x4 w; w.x = cvt_pk_bf16(v0[0], v0[1]); w.y = cvt_pk_bf16(v0[2], v0[3]); w.z = cvt_pk_bf16(v1[0], v1[1]); w.w = cvt_pk_bf16(v1[2], v1[3]);
                        if ((pn >> 1) == 3) {
                            const int c = col0 + bj * HALF, hh = c >> 6, d0 = c & 63, bb = row >> 11, tt = row & 2047;
                            bf16_t* vt = basep + ((size_t)((bb * 8 + hh) * 64 + d0)) * 2048 + tt;
                            vt[0 * 2048] = (bf16_t)(w.x & 0xffffu); vt[1 * 2048] = (bf16_t)(w.x >> 16); vt[2 * 2048] = (bf16_t)(w.y & 0xffffu); vt[3 * 2048] = (bf16_t)(w.y >> 16);
                            vt[4 * 2048] = (bf16_t)(w.z & 0xffffu); vt[5 * 2048] = (bf16_t)(w.z >> 16); vt[6 * 2048] = (bf16_t)(w.w & 0xffffu); vt[7 * 2048] = (bf16_t)(w.w >> 16);
                        } else *(u32x4*)(basep + (size_t)row * 512 + col0 + bj * HALF) = w;
                    }
                }
        } else {
            const int col0 = (pn - 8) * HALF + wc * 32 + 8 * fq;
#pragma unroll
            for (int ai = 0; ai < 2; ++ai)
#pragma unroll
                for (int m = 0; m < 4; ++m) {
                    const int row = row0 + ai * HALF + m * 16;
                    const float rs = rsv[ai][m];
                    float r8[8], s8[8];
#pragma unroll
                    for (int n = 0; n < 2; ++n)
#pragma unroll
                        for (int e = 0; e < 4; ++e) { const float ea = __builtin_amdgcn_exp2f(acc[ai][0][m][n][e] * (-rs * LOG2E_F)), eb = __builtin_fminf(__builtin_amdgcn_exp2f(acc[ai][1][m][n][e] * (-rs * LOG2E_F)), 1e18f);
                            const float opb = 1.0f + eb;
                            s8[4 * n + e] = __builtin_amdgcn_rcpf(opb); r8[4 * n + e] = opb * __builtin_amdgcn_rcpf(1.0f + ea); }
                    u32x4 w; w.x = cvt_pk_bf16(r8[0], r8[1]); w.y = cvt_pk_bf16(r8[2], r8[3]); w.z = cvt_pk_bf16(r8[4], r8[5]); w.w = cvt_pk_bf16(r8[6], r8[7]);
                    *(u32x4*)(GR + (size_t)row * 1024 + col0) = w;
                    w.x = cvt_pk_bf16(s8[0], s8[1]); w.y = cvt_pk_bf16(s8[2], s8[3]); w.z = cvt_pk_bf16(s8[4], s8[5]); w.w = cvt_pk_bf16(s8[6], s8[7]);
                    *(u32x4*)(GS + (size_t)row * 1024 + col0) = w;
                }
        }
    }
};
struct EpiBranchF {
    static constexpr bool PERM = true, AFTER_DRAIN = false, MID = true;
    bf16_t* Mb; const bf16_t* GR; const bf16_t* GS;
    __device__ __forceinline__ void mid(f32x4 (&acc)[2][2][4][2], const Unit& u, int wr, int wc, int fr, int fq) const {
        int row0 = u.pm * BM + wr * 64 + fr; const int col0 = u.pn * BM + wc * 32 + 8 * fq;
        asm volatile("" : "+v"(row0));
        u32x4 gw[2][4][2];
#pragma unroll
        for (int ai = 0; ai < 2; ++ai)
#pragma unroll
            for (int m = 0; m < 4; ++m)
#pragma unroll
                for (int bj = 0; bj < 2; ++bj) gw[ai][m][bj] = *(const u32x4*)(GR + (size_t)(row0 + ai * HALF + m * 16) * 1024 + col0 + bj * HALF);
#pragma unroll
        for (int ai = 0; ai < 2; ++ai)
#pragma unroll
            for (int m = 0; m < 4; ++m)
#pragma unroll
                for (int bj = 0; bj < 2; ++bj) { const u32x4 w = gw[ai][m][bj]; f32x4& v0 = acc[ai][bj][m][0]; f32x4& v1 = acc[ai][bj][m][1];
                    v0[0] *= bflo(w.x); v0[1] *= bfhi(w.x); v0[2] *= bflo(w.y); v0[3] *= bfhi(w.y); v1[0] *= bflo(w.z); v1[1] *= bfhi(w.z); v1[2] *= bflo(w.w); v1[3] *= bfhi(w.w); }
    }
    __device__ __forceinline__ void operator()(const f32x4 (&acc)[2][2][4][2], const Unit& u, int wr, int wc, int fr, int fq) const {
        const int row0 = u.pm * BM + wr * 64 + fr, col0 = u.pn * BM + wc * 32 + 8 * fq;
        u32x4 gwv[2][4][2];
#pragma unroll
        for (int ai = 0; ai < 2; ++ai)
#pragma unroll
            for (int m = 0; m < 4; ++m)
#pragma unroll
                for (int bj = 0; bj < 2; ++bj) gwv[ai][m][bj] = *(const u32x4*)(GS + (size_t)(row0 + ai * HALF + m * 16) * 1024 + col0 + bj * HALF);
#pragma unroll
        for (int ai = 0; ai < 2; ++ai)
#pragma unroll
            for (int m = 0; m < 4; ++m)
#pragma unroll
                for (int bj = 0; bj < 2; ++bj) {
                    const size_t off = (size_t)(row0 + ai * HALF + m * 16) * 1024 + col0 + bj * HALF;
                    const u32x4 gw = gwv[ai][m][bj];
                    f32x4 v0 = acc[ai][bj][m][0], v1 = acc[ai][bj][m][1];
                    v0[0] *= bflo(gw.x); v0[1] *= bfhi(gw.x); v0[2] *= bflo(gw.y); v0[3] *= bfhi(gw.y); v1[0] *= bflo(gw.z); v1[1] *= bfhi(gw.z); v1[2] *= bflo(gw.w); v1[3] *= bfhi(gw.w);
                    u32x4 w; w.x = cvt_pk_bf16(v0[0], v0[1]); w.y = cvt_pk_bf16(v0[2], v0[3]); w.z = cvt_pk_bf16(v1[0], v1[1]); w.w = cvt_pk_bf16(v1[2], v1[3]);
                    *(u32x4*)(Mb + off) = w;
                }
    }
};
struct EpiDownFinal {
    static constexpr bool PERM = true, AFTER_DRAIN = true, MID = false;
    const bf16_t* base; float* out; const float* gain; float* xbuf; unsigned* cnt; float alpha;
    __device__ __forceinline__ void fused(f32x4 (&acc)[2][2][4][2], const Unit& u, int wr, int wc, int fr, int fq, PG8_LAS unsigned char* lds, int wid, int lane) const {
        PG8_LAS float* P = (PG8_LAS float*)lds;
        PG8_LAS float* S = (PG8_LAS float*)(lds + 4096);
        const int row0 = u.pm * BM + wr * 64 + fr, col0 = u.pn * BM + wc * 32 + 8 * fq;
        u32x4 bwv[2][4][2];
#pragma unroll
        for (int ai = 0; ai < 2; ++ai)
#pragma unroll
            for (int m = 0; m < 4; ++m)
#pragma unroll
                for (int bj = 0; bj < 2; ++bj) bwv[ai][m][bj] = *(const u32x4*)(base + (size_t)(row0 + ai * HALF + m * 16) * 1024 + col0 + bj * HALF);
#pragma unroll
        for (int ai = 0; ai < 2; ++ai)
#pragma unroll
            for (int m = 0; m < 4; ++m) {
                float s = 0.f;
#pragma unroll
                for (int bj = 0; bj < 2; ++bj) {
                    const u32x4 bw = bwv[ai][m][bj];
                    const f32x4 b0 = (f32x4){bflo(bw.x), bfhi(bw.x), bflo(bw.y), bfhi(bw.y)}, b1 = (f32x4){bflo(bw.z), bfhi(bw.z), bflo(bw.w), bfhi(bw.w)};
                    const f32x4 h0 = b0 + acc[ai][bj][m][0] * alpha, h1 = b1 + acc[ai][bj][m][1] * alpha;
                    acc[ai][bj][m][0] = h0; acc[ai][bj][m][1] = h1;
                    s += ((h0[0] * h0[0] + h0[1] * h0[1]) + (h0[2] * h0[2] + h0[3] * h0[3])) + ((h1[0] * h1[0] + h1[1] * h1[1]) + (h1[2] * h1[2] + h1[3] * h1[3]));
                }
                s += __shfl_xor(s, 16); s += __shfl_xor(s, 32);
                if (fq == 0) P[(ai * HALF + wr * 64 + m * 16 + fr) * 4 + wc] = s;
            }
        asm volatile("s_waitcnt lgkmcnt(0)" ::: "memory"); __builtin_amdgcn_s_barrier(); asm volatile("" ::: "memory");
        const int row = wid * 32 + (lane & 31);
        if (lane < 32) { const float t = (P[row * 4 + 0] + P[row * 4 + 1]) + (P[row * 4 + 2] + P[row * 4 + 3]);
            __hip_atomic_store(xbuf + (size_t)(u.pm * BM + row) * 4 + u.pn, t, __ATOMIC_RELAXED, __HIP_MEMORY_SCOPE_AGENT); }
        asm volatile("s_waitcnt vmcnt(0)" ::: "memory");
        if (lane == 0) __hip_atomic_fetch_add(cnt + 64 * u.pm, 1u, __ATOMIC_RELAXED, __HIP_MEMORY_SCOPE_AGENT);
        if (wid == 0) {
            unsigned sp = 0;
            while ((unsigned)__builtin_amdgcn_readfirstlane(__hip_atomic_load(cnt + 64 * u.pm, __ATOMIC_RELAXED, __HIP_MEMORY_SCOPE_AGENT)) < 32u) { __builtin_amdgcn_s_sleep(2); if (++sp > (1u << 20)) break; }
            __builtin_amdgcn_fence(__ATOMIC_ACQUIRE, "agent");
        }
        asm volatile("s_waitcnt vmcnt(0) lgkmcnt(0)" ::: "memory"); __builtin_amdgcn_s_barrier(); asm volatile("" ::: "memory");
        if (lane < 32) { const float* slot = xbuf + (size_t)(u.pm * BM + row) * 4; float t = 0.f;
#pragma unroll
            for (int k = 0; k < 4; ++k) t += __hip_atomic_load(slot + k, __ATOMIC_RELAXED, __HIP_MEMORY_SCOPE_AGENT);
            S[row] = __builtin_amdgcn_rsqf(t * (1.0f / 1024.0f) + RMS_EPS_F); }
        asm volatile("s_waitcnt lgkmcnt(0)" ::: "memory"); __builtin_amdgcn_s_barrier(); asm volatile("" ::: "memory");
#pragma unroll
        for (int bj = 0; bj < 2; ++bj) {
            const f32x4 g0 = *(const f32x4*)(gain + col0 + bj * HALF), g1 = *(const f32x4*)(gain + col0 + bj * HALF + 4);
#pragma unroll
            for (int ai = 0; ai < 2; ++ai)
#pragma unroll
                for (int m = 0; m < 4; ++m) {
                    const int r = ai * HALF + wr * 64 + m * 16 + fr; const float rs = S[r];
                    const size_t off = (size_t)(u.pm * BM + r) * 1024 + col0 + bj * HALF;
                    *(f32x4*)(out + off) = acc[ai][bj][m][0] * rs * g0; *(f32x4*)(out + off + 4) = acc[ai][bj][m][1] * rs * g1;
                }
        }
    }
};

struct EpiDownF32 {
    static constexpr bool PERM = true, AFTER_DRAIN = false, MID = false;
    const bf16_t* base; float* out; float alpha;
    __device__ __forceinline__ void operator()(const f32x4 (&acc)[2][2][4][2], const Unit& u, int wr, int wc, int fr, int fq) const {
        const int row0 = u.pm * BM + wr * 64 + fr, col0 = u.pn * BM + wc * 32 + 8 * fq;
#pragma unroll
        for (int ai = 0; ai < 2; ++ai)
#pragma unroll
            for (int m = 0; m < 4; ++m)
#pragma unroll
                for (int bj = 0; bj < 2; ++bj) {
                    const size_t off = (size_t)(row0 + ai * HALF + m * 16) * 1024 + col0 + bj * HALF;
                    const u32x4 bw = *(const u32x4*)(base + off);
                    const f32x4 b0 = (f32x4){bflo(bw.x), bfhi(bw.x), bflo(bw.y), bfhi(bw.y)}, b1 = (f32x4){bflo(bw.z), bfhi(bw.z), bflo(bw.w), bfhi(bw.w)};
                    *(f32x4*)(out + off) = b0 + acc[ai][bj][m][0] * alpha; *(f32x4*)(out + off + 4) = b1 + acc[ai][bj][m][1] * alpha;
                }
    }
};
template <class Epi, class Sched, bool ALIGN_EPI = false, bool SP2 = false>
__device__ __forceinline__ void gemm_phase(PG8_LAS unsigned char* lds, const Gemm g, const Sched& S, const Epi& E) {
    const int tid = threadIdx.x, wid = __builtin_amdgcn_readfirstlane(tid >> 6), lane = tid & 63, wr = wid >> 2, wc = wid & 3, fr = lane & 15, fq = lane >> 4;
    const int K = g.K, nt = K / BK;
    unsigned voffA[2], voffB[2];
#pragma unroll
    for (int i = 0; i < 2; ++i) { int R, C; stage_rc(tid * 16 + i * 8192, R, C); const int Rb = Epi::PERM ? ((R & ~31) + perm32(R & 31)) : R;
        voffA[i] = (unsigned)(R * K + C) * 2u; voffB[i] = (unsigned)(Rb * K + C) * 2u; }
    const size_t kstep = (size_t)(BK * 2);
    const size_t hstep = (size_t)HALF * K * 2;
    const size_t tstep = 2 * hstep;
    const unsigned ldsw = (unsigned)wid * 1024u;
    const int aoff = lds_byte(wr * 64 + fr, fq * 8), boff = lds_byte(wc * 32 + fr, fq * 8);
#define PG8_SA(b, h) (((b) * 2 + (h)) * HTB)
#define PG8_SB(b, h) ((4 + (b) * 2 + (h)) * HTB)
#define PG8_STAGE(bufoff, gbase, voff) do { _Pragma("unroll") for (int _i = 0; _i < 2; ++_i) \
        __builtin_amdgcn_global_load_lds((const unsigned*)((const char*)(gbase) + (voff)[_i]), (PG8_LAS unsigned*)(lds + (bufoff) + ldsw + _i * 8192), 16, 0, 0); } while (0)
#define PG8_LDA(dst, b, h) do { _Pragma("unroll") for (int m = 0; m < 4; ++m) _Pragma("unroll") for (int k = 0; k < 2; ++k) dst[m][k] = *(const PG8_LAS bf16x8*)(lds + PG8_SA(b, h) + aoff + m * 2048 + k * 1024); } while (0)
#define PG8_LDB(dst, b, h) do { _Pragma("unroll") for (int n = 0; n < 2; ++n) _Pragma("unroll") for (int k = 0; k < 2; ++k) dst[n][k] = *(const PG8_LAS bf16x8*)(lds + PG8_SB(b, h) + boff + n * 2048 + k * 1024); } while (0)
#define PG8_MMA(ai, bj, At, Bt) do { __builtin_amdgcn_s_setprio(1); _Pragma("unroll") for (int m = 0; m < 4; ++m) _Pragma("unroll") for (int n = 0; n < 2; ++n) _Pragma("unroll") for (int k = 0; k < 2; ++k) \
        acc[ai][bj][m][n] = __builtin_amdgcn_mfma_f32_16x16x32_bf16(Bt[n][k], At[m][k], acc[ai][bj][m][n], 0, 0, 0); __builtin_amdgcn_s_setprio(0); } while (0)
#define PG8_WAIT_V(n) asm volatile("s_waitcnt vmcnt(" #n ")" ::: "memory")
#define PG8_WAIT_L(n) asm volatile("s_waitcnt lgkmcnt(" #n ")" ::: "memory")
#define PG8_BAR __builtin_amdgcn_s_barrier()
#define PG8_SCHED __builtin_amdgcn_sched_barrier(0)
    Unit cur, nxt; int ui = 0;
    if (!S.next(0, cur)) return;
    f32x4 acc[2][2][4][2];
#pragma unroll
    for (int a = 0; a < 2; ++a)
#pragma unroll
        for (int b = 0; b < 2; ++b)
#pragma unroll
            for (int m = 0; m < 4; ++m)
#pragma unroll
                for (int n = 0; n < 2; ++n) acc[a][b][m][n] = (f32x4){0.f, 0.f, 0.f, 0.f};
    bf16x8 At[4][2], B0[2][2], B1[2][2];
    const char* cA = (const char*)g.A + (size_t)cur.pm * tstep; const char* cB = (const char*)g.Bt + (size_t)cur.pn * tstep;
    S.a_ready(cur);
    if constexpr (SP2) {
        PG8_STAGE(PG8_SB(0, 0), cB, voffB); PG8_STAGE(PG8_SB(0, 1), cB + hstep, voffB); PG8_STAGE(PG8_SA(0, 0), cA, voffA); PG8_STAGE(PG8_SA(0, 1), cA + hstep, voffA);
        if (wr == 1) PG8_BAR;
        PG8_WAIT_V(2); PG8_BAR;
        PG8_STAGE(PG8_SB(1, 0), cB + kstep, voffB); PG8_STAGE(PG8_SA(1, 0), cA + kstep, voffA); PG8_STAGE(PG8_SB(1, 1), cB + hstep + kstep, voffB);
        PG8_WAIT_V(6); PG8_BAR;
    } else {
        PG8_STAGE(PG8_SB(0, 0), cB, voffB); PG8_STAGE(PG8_SA(0, 0), cA, voffA); PG8_STAGE(PG8_SB(0, 1), cB + hstep, voffB); PG8_STAGE(PG8_SA(0, 1), cA + hstep, voffA);
        if (wr == 1) PG8_BAR;
        PG8_WAIT_V(4); PG8_BAR;
        PG8_STAGE(PG8_SB(1, 0), cB + kstep, voffB); PG8_STAGE(PG8_SA(1, 0), cA + kstep, voffA); PG8_STAGE(PG8_SB(1, 1), cB + hstep + kstep, voffB);
        PG8_WAIT_V(6); PG8_BAR;
    }
    for (;;) {
        const bool has_next = S.next(ui + 1, nxt);
        const char* nA = has_next ? (const char*)g.A + (size_t)nxt.pm * tstep : cA; const char* nB = has_next ? (const char*)g.Bt + (size_t)nxt.pn * tstep : cB;
        for (int t = 0; t < nt; t += 2) {
            if constexpr (Epi::MID) { if (t == (nt >> 1)) E.mid(acc, cur, wr, wc, fr, fq); }
            const bool last = (t == nt - 2);
            const char* a1 = cA + (size_t)(t + 1) * kstep;
            const char* a2 = last ? nA : cA + (size_t)(t + 2) * kstep; const char* b2 = last ? nB : cB + (size_t)(t + 2) * kstep;
            const char* a3 = a2 + kstep; const char* b3 = b2 + kstep;
            if (last && has_next) S.a_ready(nxt);
            if constexpr (SP2) {
            PG8_LDB(B0, 0, 0); PG8_LDB(B1, 0, 1); PG8_SCHED; PG8_LDA(At, 0, 0); PG8_STAGE(PG8_SA(1, 1), a1 + hstep, voffA);
            PG8_WAIT_V(8); PG8_WAIT_L(0); PG8_BAR; PG8_MMA(0, 0, At, B0); PG8_MMA(0, 1, At, B1); PG8_BAR; PG8_SCHED;
            PG8_LDA(At, 0, 1); PG8_STAGE(PG8_SB(0, 0), b2, voffB); PG8_STAGE(PG8_SB(0, 1), b2 + hstep, voffB); PG8_STAGE(PG8_SA(0, 0), a2, voffA);
            PG8_WAIT_V(8); PG8_WAIT_L(0); PG8_BAR; PG8_MMA(1, 0, At, B0); PG8_MMA(1, 1, At, B1); PG8_BAR; PG8_SCHED;
            PG8_LDB(B0, 1, 0); PG8_LDB(B1, 1, 1); PG8_SCHED; PG8_LDA(At, 1, 0); PG8_STAGE(PG8_SA(0, 1), a2 + hstep, voffA);
            PG8_WAIT_V(8); PG8_WAIT_L(0); PG8_BAR; PG8_MMA(0, 0, At, B0); PG8_MMA(0, 1, At, B1); PG8_BAR; PG8_SCHED;
            PG8_LDA(At, 1, 1); PG8_STAGE(PG8_SB(1, 0), b3, voffB); PG8_STAGE(PG8_SB(1, 1), b3 + hstep, voffB); PG8_STAGE(PG8_SA(1, 0), a3, voffA);
            PG8_WAIT_V(8); PG8_WAIT_L(0); PG8_BAR; PG8_MMA(1, 0, At, B0); PG8_MMA(1, 1, At, B1); PG8_BAR; PG8_SCHED;
            } else {
            PG8_LDB(B0, 0, 0); PG8_SCHED; PG8_LDA(At, 0, 0); PG8_STAGE(PG8_SA(1, 1), a1 + hstep, voffA);
            PG8_WAIT_L(8); PG8_BAR; PG8_WAIT_L(0); PG8_MMA(0, 0, At, B0); PG8_BAR; PG8_SCHED;
            PG8_LDB(B1, 0, 1); PG8_STAGE(PG8_SB(0, 0), b2, voffB);
            PG8_BAR; PG8_WAIT_L(0); PG8_MMA(0, 1, At, B1); PG8_BAR;
            PG8_LDA(At, 0, 1); PG8_STAGE(PG8_SA(0, 0), a2, voffA);
            PG8_BAR; PG8_WAIT_L(0); PG8_MMA(1, 0, At, B0); PG8_BAR; PG8_SCHED;
            PG8_STAGE(PG8_SB(0, 1), b2 + hstep, voffB);
            PG8_WAIT_V(6); PG8_BAR; PG8_MMA(1, 1, At, B1); PG8_BAR;
            PG8_LDB(B0, 1, 0); PG8_SCHED; PG8_LDA(At, 1, 0); PG8_STAGE(PG8_SA(0, 1), a2 + hstep, voffA);
            PG8_WAIT_L(8); PG8_BAR; PG8_WAIT_L(0); PG8_MMA(0, 0, At, B0); PG8_BAR; PG8_SCHED;
            PG8_LDB(B1, 1, 1); PG8_STAGE(PG8_SB(1, 0), b3, voffB);
            PG8_BAR; PG8_WAIT_L(0); PG8_MMA(0, 1, At, B1); PG8_BAR;
            PG8_LDA(At, 1, 1); PG8_STAGE(PG8_SA(1, 0), a3, voffA);
            PG8_BAR; PG8_WAIT_L(0); PG8_MMA(1, 0, At, B0); PG8_BAR; PG8_SCHED;
            PG8_STAGE(PG8_SB(1, 1), b3 + hstep, voffB);
            PG8_WAIT_V(6); PG8_BAR; PG8_MMA(1, 1, At, B1); PG8_BAR;
            }
        }
        if constexpr (ALIGN_EPI) { if (wr == 0) PG8_BAR; }
        if constexpr (!Epi::AFTER_DRAIN) { E(acc, cur, wr, wc, fr, fq); S.done(cur); }
        if (!has_next) break;
#pragma unroll
        for (int a = 0; a < 2; ++a)
#pragma unroll
            for (int b = 0; b < 2; ++b)
#pragma unroll
                for (int m = 0; m < 4; ++m)
#pragma unroll
                    for (int n = 0; n < 2; ++n) acc[a][b][m][n] = (f32x4){0.f, 0.f, 0.f, 0.f};
        cur = nxt; cA = nA; cB = nB; ++ui;
        if constexpr (ALIGN_EPI) { if (wr == 1) PG8_BAR; }
    }
    PG8_WAIT_V(0);
    if constexpr (!ALIGN_EPI) { if (wr == 0) PG8_BAR; }
    PG8_BAR;
    if constexpr (Epi::AFTER_DRAIN) { E.fused(acc, cur, wr, wc, fr, fq, lds, wid, lane); S.done(cur); }
#undef PG8_SA
#undef PG8_SB
#undef PG8_STAGE
#undef PG8_LDA
#undef PG8_LDB
#undef PG8_MMA
#undef PG8_WAIT_V
#undef PG8_WAIT_L
#undef PG8_BAR
#undef PG8_SCHED
}
}
#define LAS __attribute__((address_space(3)))
typedef unsigned short bf16;
typedef unsigned v4u __attribute__((ext_vector_type(4)));
typedef unsigned v2u __attribute__((ext_vector_type(2)));
typedef float f32x4 __attribute__((ext_vector_type(4)));
typedef float f32x16 __attribute__((ext_vector_type(16)));
typedef short bf16x8 __attribute__((ext_vector_type(8)));
constexpr int T = 16384, D = 1024, FF = 2816, SEQ = 2048, NHEAD = 8, PW = 512, INW = 4096;
constexpr float RMS_EPS = 1e-6f;
constexpr int NWAVES = 8, LDS_BYTES = 147456;
constexpr int NPHASE = 10;
constexpr int LDSCTL_OFF = 131072, MISC_OFF = LDSCTL_OFF + 320;
constexpr int RSL_OFF = LDSCTL_OFF + 1024;
constexpr int CW_BAR = 4096;
constexpr int CW_CNT = 12288;
constexpr size_t CTL_ZERO_BYTES = 65536;
#ifndef PROBE_REPEAT
#define PROBE_REPEAT -1
#endif
#ifndef PROBE_DOUBLE_SEAM
#define PROBE_DOUBLE_SEAM 0
#endif
#ifndef PROBE_ATTN2
#define PROBE_ATTN2 0
#endif
#ifndef PROBE_POOL2
#define PROBE_POOL2 0
#endif
#ifndef PROBE_NOEXIT
#define PROBE_NOEXIT 0
#endif
#ifndef PROBE_SPLIT
#define PROBE_SPLIT -1
#endif
#ifndef PHASE_MASK
#define PHASE_MASK 1023
#endif
constexpr size_t MiB = 1u << 20;
constexpr size_t WS_W1GU = 2 * MiB, WS_W1D = 13 * MiB, WS_WIN = 19 * MiB, WS_WCOMB = 27 * MiB, WS_WA = 28 * MiB, WS_WOUT = 29 * MiB, WS_W2GU = 31 * MiB, WS_W2D = 42 * MiB;
constexpr size_t WS_SSQ = 48 * MiB;
constexpr size_t WS_HB = 52 * MiB;
constexpr size_t WS_BIG = 84 * MiB;
constexpr size_t WS_P4 = WS_BIG, WS_G = WS_BIG + 64 * MiB, WS_MB = WS_BIG + 32 * MiB;
constexpr size_t WS_PO = WS_BIG + 128 * MiB;
constexpr size_t WS_END = WS_PO + 32 * MiB;
static_assert(WS_W2D + (size_t)D * FF * 2 <= WS_SSQ && WS_SSQ + 3 * MiB <= WS_HB && WS_HB + 32 * MiB <= WS_BIG && (size_t)T * FF * 2 <= 128 * MiB && WS_END <= 256 * MiB, "d_ws map");

__device__ __forceinline__ unsigned f2bf(float f) { unsigned u = __builtin_bit_cast(unsigned, f); return (u + 0x7fffu + ((u >> 16) & 1u)) >> 16; }
__device__ __forceinline__ unsigned pk2(float lo, float hi) { return pg8::cvt_pk_bf16(lo, hi); }
__device__ __forceinline__ float bflo(unsigned w) { return __builtin_bit_cast(float, w << 16); }
__device__ __forceinline__ float bfhi(unsigned w) { return __builtin_bit_cast(float, w & 0xffff0000u); }
__device__ __forceinline__ float wave_sum(float v) {
#pragma unroll
    for (int o = 1; o < 64; o <<= 1) v += __shfl_xor(v, o);
    return v;
}
#define LDS_WAIT() asm volatile("s_waitcnt lgkmcnt(0)" ::: "memory")

__device__ __forceinline__ void tr_item(const float* W, int K, int N, bf16* WT, int ldw, int koff, const float* ks, int il, int ib, int item, LAS float* scr, int lane) {
    const int nblk = N / 64, kb = item / nblk, nb = item % nblk, k0 = 64 * kb, n0 = 64 * nb;
    int drow = n0;
    if (il > 0 && n0 >= ib) { const int second = (n0 - ib) >= il ? 1 : 0, j = n0 - ib - second * il; drow = ib + 256 * (j / 128) + 128 * second + (j % 128); }
    float va[32], vb[32];
#pragma unroll
    for (int i = 0; i < 32; ++i) { const int kk = 2 * i + (lane >> 5); const float* p = W + (size_t)(k0 + kk) * N + n0 + (lane & 31); va[i] = p[0]; vb[i] = p[32]; }
    if (ks) {
#pragma unroll
        for (int i = 0; i < 32; ++i) { const float sc = ks[k0 + 2 * i + (lane >> 5)]; va[i] *= sc; vb[i] *= sc; }
    }
    const int c = lane & 7;
#pragma unroll
    for (int h = 0; h < 2; ++h) {
#pragma unroll
        for (int i = 0; i < 32; ++i) scr[(2 * i + (lane >> 5)) * 33 + (lane & 31)] = h ? vb[i] : va[i];
        LDS_WAIT(); asm volatile("" ::: "memory");
#pragma unroll
        for (int j = 0; j < 4; ++j) { const int n = (lane >> 3) + 8 * j; const LAS float* s = scr + (8 * c) * 33 + n;
            v4u o; o.x = pk2(s[0 * 33], s[1 * 33]); o.y = pk2(s[2 * 33], s[3 * 33]); o.z = pk2(s[4 * 33], s[5 * 33]); o.w = pk2(s[6 * 33], s[7 * 33]);
            *(v4u*)(WT + (size_t)(drow + 32 * h + n) * ldw + koff + k0 + 8 * c) = o; }
        LDS_WAIT(); asm volatile("" ::: "memory");
    }
}
__device__ __forceinline__ void comb_item(const float* wg, const float* psc, const float* wbp, bf16* WC, int item, int lane) {
    const int nb = item >> 6, kc = item & 63, n = nb * 64 + lane, k0 = kc * 8, g = k0 >> 7, c0 = k0 & 127;
    float acc[8];
#pragma unroll
    for (int i = 0; i < 8; ++i) acc[i] = 0.f;
    const float* wrow = wg + (size_t)(g * 128 + c0) * 128;
#pragma unroll 32
    for (int d = 0; d < 128; ++d) {
        const float wv = wbp[(size_t)(g * 128 + d) * 1024 + n] * psc[g * 128 + d];
#pragma unroll
        for (int i = 0; i < 8; ++i) acc[i] += wrow[i * 128 + d] * wv;
    }
    v4u o; o.x = pk2(acc[0], acc[1]); o.y = pk2(acc[2], acc[3]); o.z = pk2(acc[4], acc[5]); o.w = pk2(acc[6], acc[7]);
    *(v4u*)(WC + (size_t)n * 1024 + k0) = o;
}
__device__ __forceinline__ void comb_block(const float* wg, const float* psc, const float* wbp, bf16* WC, int blk, LAS unsigned char* lds, int wave, int lane, int tid) {
    const int kc = blk >> 2, nq = blk & 3, k0 = kc * 8, g = k0 >> 7, c0 = k0 & 127, d0 = 16 * wave;
    const float* wrow = wg + (size_t)(g * 128 + c0) * 128 + d0;
    const float* wb = wbp + (size_t)(g * 128 + d0) * 1024 + nq * 256 + 4 * lane;
    f32x4 wv[16];
#pragma unroll
    for (int dd = 0; dd < 16; ++dd) wv[dd] = *(const f32x4*)(wb + (size_t)dd * 1024);
    f32x4 acc[8];
#pragma unroll
    for (int i = 0; i < 8; ++i) acc[i] = (f32x4){0.f, 0.f, 0.f, 0.f};
#pragma unroll
    for (int dd = 0; dd < 16; ++dd) { const f32x4 v = wv[dd] * psc[g * 128 + d0 + dd];
#pragma unroll
        for (int i = 0; i < 8; ++i) acc[i] += v * wrow[i * 128 + dd]; }
    LAS f32x4* red = (LAS f32x4*)lds;
#pragma unroll
    for (int i = 0; i < 8; ++i) red[(wave * 8 + i) * 64 + lane] = acc[i];
    __syncthreads();
    const int nl = tid & 255, kh = tid >> 8; const LAS float* rf = (const LAS float*)lds;
    float o[4];
#pragma unroll
    for (int j = 0; j < 4; ++j) { float s = 0.f;
#pragma unroll
        for (int w = 0; w < 8; ++w) s += rf[(((w * 8 + 4 * kh + j) * 64 + (nl >> 2)) << 2) + (nl & 3)];
        o[j] = s; }
    v2u pk; pk.x = pk2(o[0], o[1]); pk.y = pk2(o[2], o[3]);
    *(v2u*)(WC + (size_t)(nq * 256 + nl) * 1024 + k0 + 4 * kh) = pk;
    __syncthreads();
}
__device__ __forceinline__ void rms_rows4_bf16(const float* x4, const float* gain, bf16* o4, int lane) {
    const f32x4* gr = (const f32x4*)gain + lane;
    f32x4 v[4][4]; float s[4];
#pragma unroll
    for (int r = 0; r < 4; ++r)
#pragma unroll
        for (int j = 0; j < 4; ++j) v[r][j] = ((const f32x4*)(x4 + (size_t)r * D) + lane)[64 * j];
#pragma unroll
    for (int r = 0; r < 4; ++r) { s[r] = 0.f;
#pragma unroll
        for (int j = 0; j < 4; ++j) s[r] += (v[r][j].x * v[r][j].x + v[r][j].y * v[r][j].y) + (v[r][j].z * v[r][j].z + v[r][j].w * v[r][j].w); }
#pragma unroll
    for (int r = 0; r < 4; ++r) {
        const float rs = 1.0f / sqrtf(wave_sum(s[r]) * (1.0f / D) + RMS_EPS);
        unsigned long long* o8 = (unsigned long long*)(o4 + (size_t)r * D) + lane;
#pragma unroll
        for (int j = 0; j < 4; ++j) { const f32x4 gv = gr[64 * j]; const f32x4 o = v[r][j] * rs * gv;
            o8[64 * j] = (unsigned long long)pk2(o.x, o.y) | ((unsigned long long)pk2(o.z, o.w) << 32); }
    }
}
__device__ __forceinline__ void xb_rows4(const float* x4, bf16* o4, float* ssq4, int lane) {
    f32x4 v[4][4]; float s[4];
#pragma unroll
    for (int r = 0; r < 4; ++r)
#pragma unroll
        for (int j = 0; j < 4; ++j) v[r][j] = ((const f32x4*)(x4 + (size_t)r * D) + lane)[64 * j];
#pragma unroll
    for (int r = 0; r < 4; ++r) { s[r] = 0.f;
#pragma unroll
        for (int j = 0; j < 4; ++j) s[r] += (v[r][j].x * v[r][j].x + v[r][j].y * v[r][j].y) + (v[r][j].z * v[r][j].z + v[r][j].w * v[r][j].w); }
#pragma unroll
    for (int r = 0; r < 4; ++r) {
        const float t = wave_sum(s[r]);
        unsigned long long* o8 = (unsigned long long*)(o4 + (size_t)r * D) + lane;
#pragma unroll
        for (int j = 0; j < 4; ++j) o8[64 * j] = (unsigned long long)pk2(v[r][j].x, v[r][j].y) | ((unsigned long long)pk2(v[r][j].z, v[r][j].w) << 32);
        if (lane < 16) ssq4[r * 16 + lane] = lane ? 0.f : t;
    }
}
__device__ __forceinline__ void rms_row_f32(float* xrow, const float* gain, int lane) {
    f32x4* xr = (f32x4*)xrow + lane; const f32x4* gr = (const f32x4*)gain + lane;
    f32x4 v[4]; float s = 0.f;
#pragma unroll
    for (int j = 0; j < 4; ++j) { v[j] = xr[64 * j]; s += (v[j].x * v[j].x + v[j].y * v[j].y) + (v[j].z * v[j].z + v[j].w * v[j].w); }
    const float rs = 1.0f / sqrtf(wave_sum(s) * (1.0f / D) + RMS_EPS);
#pragma unroll
    for (int j = 0; j < 4; ++j) { const f32x4 gv = gr[64 * j]; xr[64 * j] = v[j] * rs * gv; }
}

namespace sb {
__device__ __forceinline__ void attn_wave(int bh, int rb, const bf16* Qp, const bf16* Kp, const bf16* Vt, bf16* Op  , int lane) {
    const int r32 = lane & 31, hi = lane >> 5, b = bh >> 3, h = bh & 7;
    const size_t rowbase = (size_t)b * SEQ;
    const int tq = rb * 32 + r32;
    const int kap = 16 * ((r32 >> 2) & 1) + (r32 & 3) + 4 * (r32 >> 3);
    bf16x8 qr[4];
    { const bf16* qrow = Qp + (rowbase + tq) * 512 + h * 64 + hi * 8;
#pragma unroll
      for (int s = 0; s < 4; ++s) qr[s] = *(const bf16x8*)(qrow + s * 16); }
    const bf16* kbase = Kp + (rowbase + kap) * 512 + h * 64 + hi * 8;
    const bf16* vbase = Vt + ((size_t)bh * 64 + r32) * 2048 + 16 * hi;
    f32x16 o0, o1;
#pragma unroll
    for (int r = 0; r < 16; ++r) { o0[r] = 0.f; o1[r] = 0.f; }
    float R = 1.0f;
#define SB_LOAD(KF, VF, JB) do { const int jl_ = (JB) > 0 ? (JB) : 0; _Pragma("unroll") for (int s = 0; s < 4; ++s) { \
        KF[s] = *(const bf16x8*)(kbase + (size_t)(32 * jl_) * 512 + 16 * s); VF[s] = *(const bf16x8*)(vbase + (size_t)(s >> 1) * 32 * 2048 + 32 * jl_ + 8 * (s & 1)); } } while (0)
#define SB_BLOCK(KF, VF, JB, MASKED) do { \
        f32x16 c; _Pragma("unroll") for (int r = 0; r < 16; ++r) c[r] = 0.f; \
        _Pragma("unroll") for (int s = 0; s < 4; ++s) c = __builtin_amdgcn_mfma_f32_32x32x16_bf16(KF[s], qr[s], c, 0, 0, 0); \
        const int lim = tq - (32 * (JB) + 16 * hi);                                \
        float mm[16]; \
        _Pragma("unroll") for (int r = 0; r < 16; ++r) { const float e = __builtin_amdgcn_exp2f(c[r]); float m = __builtin_amdgcn_rcpf(1.0f + e); if (MASKED && r >= lim) m = 1.0f; mm[r] = m; } \
        const float Tp = (((mm[0] * mm[1]) * (mm[2] * mm[3])) * ((mm[4] * mm[5]) * (mm[6] * mm[7]))) * (((mm[8] * mm[9]) * (mm[10] * mm[11])) * ((mm[12] * mm[13]) * (mm[14] * mm[15]))); \
        const float To = __shfl_xor(Tp, 32); \
        float Rl = hi ? R : R * To;                                                \
        float av[16]; \
        _Pragma("unroll") for (int r = 15; r >= 0; --r) { const float Rn = Rl * mm[r]; av[r] = Rl - Rn; Rl = Rn; } \
        R = R * Tp * To; \
        v4u p0, p1; \
        p0.x = pg8::cvt_pk_bf16(av[0], av[1]); p0.y = pg8::cvt_pk_bf16(av[2], av[3]); p0.z = pg8::cvt_pk_bf16(av[4], av[5]); p0.w = pg8::cvt_pk_bf16(av[6], av[7]); \
        p1.x = pg8::cvt_pk_bf16(av[8], av[9]); p1.y = pg8::cvt_pk_bf16(av[10], av[11]); p1.z = pg8::cvt_pk_bf16(av[12], av[13]); p1.w = pg8::cvt_pk_bf16(av[14], av[15]); \
        const bf16x8 pb0 = __builtin_bit_cast(bf16x8, p0), pb1 = __builtin_bit_cast(bf16x8, p1); \
        o0 = __builtin_amdgcn_mfma_f32_32x32x16_bf16(VF[0], pb0, o0, 0, 0, 0); o0 = __builtin_amdgcn_mfma_f32_32x32x16_bf16(VF[1], pb1, o0, 0, 0, 0); \
        o1 = __builtin_amdgcn_mfma_f32_32x32x16_bf16(VF[2], pb0, o1, 0, 0, 0); o1 = __builtin_amdgcn_mfma_f32_32x32x16_bf16(VF[3], pb1, o1, 0, 0, 0); } while (0)
#define SB_DONE(JB) ((JB) == 0 || (!PROBE_NOEXIT && __builtin_amdgcn_ballot_w64(R != 0.0f) == 0ull))
    bf16x8 ka[4], va[4], kb2[4], vb2[4], kc[4], vc[4];
    SB_LOAD(ka, va, rb); SB_LOAD(kb2, vb2, rb - 1);
    SB_LOAD(kc, vc, rb - 2); SB_BLOCK(ka, va, rb, true);
    if (!SB_DONE(rb)) for (int jb = rb - 1;; jb -= 3) {
        SB_LOAD(ka, va, jb - 2);   SB_BLOCK(kb2, vb2, jb, false);    if (SB_DONE(jb)) break;
        SB_LOAD(kb2, vb2, jb - 3); SB_BLOCK(kc, vc, jb - 1, false);  if (SB_DONE(jb - 1)) break;
        SB_LOAD(kc, vc, jb - 4);   SB_BLOCK(ka, va, jb - 2, false);  if (SB_DONE(jb - 2)) break;
    }
#undef SB_LOAD
#undef SB_BLOCK
#undef SB_DONE
    bf16* orow = Op + (rowbase + tq) * 1024 + h * 64 + 4 * hi;
#pragma unroll
    for (int g4 = 0; g4 < 4; ++g4) {
        v2u w0; w0.x = pg8::cvt_pk_bf16(o0[4 * g4], o0[4 * g4 + 1]); w0.y = pg8::cvt_pk_bf16(o0[4 * g4 + 2], o0[4 * g4 + 3]); *(v2u*)(orow + 8 * g4) = w0;
        v2u w1; w1.x = pg8::cvt_pk_bf16(o1[4 * g4], o1[4 * g4 + 1]); w1.y = pg8::cvt_pk_bf16(o1[4 * g4 + 2], o1[4 * g4 + 3]); *(v2u*)(orow + 32 + 8 * g4) = w1;
    }
}
__device__ __forceinline__ void attn_wave2(int bh, int u, const bf16* Qp, const bf16* Kp, const bf16* Vt, bf16* Op  , int lane) {
    const int r32 = lane & 31, hi = lane >> 5, b = bh >> 3, h = bh & 7;
    const size_t rowbase = (size_t)b * SEQ;
    const int tqA = 64 * u + r32, tqB = tqA + 32;
    const int kap = 16 * ((r32 >> 2) & 1) + (r32 & 3) + 4 * (r32 >> 3);
    bf16x8 qa[4], qb[4];
    { const bf16* qrow = Qp + (rowbase + tqA) * 512 + h * 64 + hi * 8;
#pragma unroll
      for (int s = 0; s < 4; ++s) { qa[s] = *(const bf16x8*)(qrow + s * 16); qb[s] = *(const bf16x8*)(qrow + (size_t)32 * 512 + s * 16); } }
    const bf16* kbase = Kp + (rowbase + kap) * 512 + h * 64 + hi * 8;
    const bf16* vbase = Vt + ((size_t)bh * 64 + r32) * 2048 + 16 * hi;
    f32x16 oa0, oa1, ob0, ob1;
#pragma unroll
    for (int r = 0; r < 16; ++r) { oa0[r] = 0.f; oa1[r] = 0.f; ob0[r] = 0.f; ob1[r] = 0.f; }
    float RA = 1.0f, RB = 1.0f;
#define SB_LOAD(KF, VF, JB) do { const int jl_ = (JB) > 0 ? (JB) : 0; _Pragma("unroll") for (int s = 0; s < 4; ++s) { \
        KF[s] = *(const bf16x8*)(kbase + (size_t)(32 * jl_) * 512 + 16 * s); VF[s] = *(const bf16x8*)(vbase + (size_t)(s >> 1) * 32 * 2048 + 32 * jl_ + 8 * (s & 1)); } } while (0)
#define SB_CHAIN(QR, O0, O1, RR, TQ, KF, VF, JB) do { \
        f32x16 c; _Pragma("unroll") for (int r = 0; r < 16; ++r) c[r] = 0.f; \
        _Pragma("unroll") for (int s = 0; s < 4; ++s) c = __builtin_amdgcn_mfma_f32_32x32x16_bf16(KF[s], QR[s], c, 0, 0, 0); \
        const int lim = (TQ) - (32 * (JB) + 16 * hi); \
        float mm[16]; \
        _Pragma("unroll") for (int r = 0; r < 16; ++r) { const float e = __builtin_amdgcn_exp2f(c[r]); float m = __builtin_amdgcn_rcpf(1.0f + e); if (r >= lim) m = 1.0f; mm[r] = m; } \
        const float Tp = (((mm[0] * mm[1]) * (mm[2] * mm[3])) * ((mm[4] * mm[5]) * (mm[6] * mm[7]))) * (((mm[8] * mm[9]) * (mm[10] * mm[11])) * ((mm[12] * mm[13]) * (mm[14] * mm[15]))); \
        const float To = __shfl_xor(Tp, 32); \
        float Rl = hi ? RR : RR * To; \
        float av[16]; \
        _Pragma("unroll") for (int r = 15; r >= 0; --r) { const float Rn = Rl * mm[r]; av[r] = Rl - Rn; Rl = Rn; } \
        RR = RR * Tp * To; \
        v4u p0, p1; \
        p0.x = pg8::cvt_pk_bf16(av[0], av[1]); p0.y = pg8::cvt_pk_bf16(av[2], av[3]); p0.z = pg8::cvt_pk_bf16(av[4], av[5]); p0.w = pg8::cvt_pk_bf16(av[6], av[7]); \
        p1.x = pg8::cvt_pk_bf16(av[8], av[9]); p1.y = pg8::cvt_pk_bf16(av[10], av[11]); p1.z = pg8::cvt_pk_bf16(av[12], av[13]); p1.w = pg8::cvt_pk_bf16(av[14], av[15]); \
        const bf16x8 pb0 = __builtin_bit_cast(bf16x8, p0), pb1 = __builtin_bit_cast(bf16x8, p1); \
        O0 = __builtin_amdgcn_mfma_f32_32x32x16_bf16(VF[0], pb0, O0, 0, 0, 0); O0 = __builtin_amdgcn_mfma_f32_32x32x16_bf16(VF[1], pb1, O0, 0, 0, 0); \
        O1 = __builtin_amdgcn_mfma_f32_32x32x16_bf16(VF[2], pb0, O1, 0, 0, 0); O1 = __builtin_amdgcn_mfma_f32_32x32x16_bf16(VF[3], pb1, O1, 0, 0, 0); } while (0)
#define SB_STEP(KF, VF, JB) do { SB_CHAIN(qb, ob0, ob1, RB, tqB, KF, VF, JB); SB_CHAIN(qa, oa0, oa1, RA, tqA, KF, VF, JB); } while (0)
#define SB_DONE(JB) ((JB) == 0 || __builtin_amdgcn_ballot_w64(RA != 0.0f || RB != 0.0f) == 0ull)
    const int jt = 2 * u + 1;
    bf16x8 ka[4], va[4], kb2[4], vb2[4], kc[4], vc[4];
    SB_LOAD(ka, va, jt); SB_LOAD(kb2, vb2, jt - 1); SB_LOAD(kc, vc, jt - 2);
    SB_CHAIN(qb, ob0, ob1, RB, tqB, ka, va, jt);
    for (int jb = jt - 1;; jb -= 3) {
        SB_LOAD(ka, va, jb - 2);   SB_STEP(kb2, vb2, jb);    if (SB_DONE(jb)) break;
        SB_LOAD(kb2, vb2, jb - 3); SB_STEP(kc, vc, jb - 1);  if (SB_DONE(jb - 1)) break;
        SB_LOAD(kc, vc, jb - 4);   SB_STEP(ka, va, jb - 2);  if (SB_DONE(jb - 2)) break;
    }
#undef SB_LOAD
#undef SB_CHAIN
#undef SB_STEP
#undef SB_DONE
    bf16* orow = Op + (rowbase + tqA) * 1024 + h * 64 + 4 * hi;
#pragma unroll
    for (int g4 = 0; g4 < 4; ++g4) {
        v2u w; w.x = pg8::cvt_pk_bf16(oa0[4 * g4], oa0[4 * g4 + 1]); w.y = pg8::cvt_pk_bf16(oa0[4 * g4 + 2], oa0[4 * g4 + 3]); *(v2u*)(orow + 8 * g4) = w;
        w.x = pg8::cvt_pk_bf16(oa1[4 * g4], oa1[4 * g4 + 1]); w.y = pg8::cvt_pk_bf16(oa1[4 * g4 + 2], oa1[4 * g4 + 3]); *(v2u*)(orow + 32 + 8 * g4) = w;
        w.x = pg8::cvt_pk_bf16(ob0[4 * g4], ob0[4 * g4 + 1]); w.y = pg8::cvt_pk_bf16(ob0[4 * g4 + 2], ob0[4 * g4 + 3]); *(v2u*)(orow + (size_t)32 * 1024 + 8 * g4) = w;
        w.x = pg8::cvt_pk_bf16(ob1[4 * g4], ob1[4 * g4 + 1]); w.y = pg8::cvt_pk_bf16(ob1[4 * g4 + 2], ob1[4 * g4 + 3]); *(v2u*)(orow + (size_t)32 * 1024 + 32 + 8 * g4) = w;
    }
}
}

template <int W> __device__ __forceinline__ void pool_run(const bf16* XP, bf16* PO, int t0, int ch8) {
    constexpr int RUN = 8;
    const int pos0 = t0 & (SEQ - 1); const bf16* p = XP + (size_t)t0 * 512 + ch8 * 8;
    v4u v[W - 1 + RUN];
#pragma unroll
    for (int i = 0; i < W - 1 + RUN; ++i) { const int rel = i - (W - 1), rc = (pos0 + rel >= 0) ? rel : -pos0; v[i] = *(const v4u*)(p + (long)rc * 512); }
#pragma unroll
    for (int i = 0; i < W - 1; ++i) { if (pos0 + (i - (W - 1)) < 0) v[i] = (v4u){0u, 0u, 0u, 0u}; }
    float s[8];
#pragma unroll
    for (int k = 0; k < 8; ++k) s[k] = 0.f;
#pragma unroll
    for (int i = 0; i < W - 1; ++i) { s[0] += bflo(v[i].x); s[1] += bfhi(v[i].x); s[2] += bflo(v[i].y); s[3] += bfhi(v[i].y); s[4] += bflo(v[i].z); s[5] += bfhi(v[i].z); s[6] += bflo(v[i].w); s[7] += bfhi(v[i].w); }
#pragma unroll
    for (int j = 0; j < RUN; ++j) {
        const v4u x0 = v[W - 1 + j], xo = v[j];
        s[0] += bflo(x0.x); s[1] += bfhi(x0.x); s[2] += bflo(x0.y); s[3] += bfhi(x0.y); s[4] += bflo(x0.z); s[5] += bfhi(x0.z); s[6] += bflo(x0.w); s[7] += bfhi(x0.w);
        const int cnt = (pos0 + j + 1 < W) ? pos0 + j + 1 : W; const float inv = 1.0f / (float)cnt;
        v4u o; o.x = pk2(s[0] * inv - bflo(x0.x), s[1] * inv - bfhi(x0.x)); o.y = pk2(s[2] * inv - bflo(x0.y), s[3] * inv - bfhi(x0.y));
        o.z = pk2(s[4] * inv - bflo(x0.z), s[5] * inv - bfhi(x0.z)); o.w = pk2(s[6] * inv - bflo(x0.w), s[7] * inv - bfhi(x0.w));
        *(v4u*)(PO + (size_t)(t0 + j) * 1024 + ch8 * 8) = o;
        s[0] -= bflo(xo.x); s[1] -= bfhi(xo.x); s[2] -= bflo(xo.y); s[3] -= bfhi(xo.y); s[4] -= bflo(xo.z); s[5] -= bfhi(xo.z); s[6] -= bflo(xo.w); s[7] -= bfhi(xo.w);
    }
}
__device__ __forceinline__ void pool_phase(const bf16* XP, bf16* PO, int gwp, int NGW, int lane) {
    for (int wi = gwp; wi < 4 * (T / 32); wi += NGW) {
        const int wq = wi % (T / 32), g = 3 - (wi / (T / 32) + wq) % 4, t0 = 32 * wq + 8 * (lane >> 4), ch8 = 16 * g + (lane & 15);
        if (g == 3) pool_run<16>(XP, PO, t0, ch8); else if (g == 2) pool_run<8>(XP, PO, t0, ch8); else if (g == 1) pool_run<4>(XP, PO, t0, ch8); else pool_run<2>(XP, PO, t0, ch8);
    }
}

#define XB_TMO      128
#define XB_XCNT(j)  (256  + 64 * (j))
#define XB_XSUB(j)  (1280 + 64 * (j))
#define XB_XGEN(j)  (2304 + 64 * (j))
#define XB_TOP      3328
#define XB_TOPGEN   3392
#define XCD_BAR_WORDS 3456
#define XB_SPIN_CAP (1u << 18)

__device__ __forceinline__ unsigned xb_ld(unsigned* p)              { return __hip_atomic_load(p, __ATOMIC_RELAXED, __HIP_MEMORY_SCOPE_AGENT); }
__device__ __forceinline__ unsigned xb_add(unsigned* p, unsigned v) { return __hip_atomic_fetch_add(p, v, __ATOMIC_RELAXED, __HIP_MEMORY_SCOPE_AGENT); }
__device__ __forceinline__ unsigned xb_xcc_id() { return (unsigned)__builtin_amdgcn_s_getreg((3 << 11) | 20) & 0xFu; }
#define XB_SPIN(cond, bar) do { unsigned _sp = 0; while (cond) { __builtin_amdgcn_s_sleep(1); \
    if ((++_sp & 255u) == 0u) { if (xb_ld(&(bar)[XB_TMO])) break; if (_sp > XB_SPIN_CAP) { atomicAdd(&(bar)[XB_TMO], 1u); break; } } } } while (0)

struct XcdBarrier {
    unsigned* bar; unsigned x;
    volatile LAS unsigned* st;
};

__device__ __forceinline__ XcdBarrier xcd_barrier_post(unsigned* bar, volatile LAS unsigned* st) {
    XcdBarrier b; b.bar = bar; b.x = xb_xcc_id(); b.st = st;
    if (threadIdx.x == 0) (void)xb_add(&bar[XB_XCNT(b.x)], 1u);
    return b;
}
__device__ __forceinline__ void xcd_barrier_complete(unsigned* bar, unsigned x, unsigned& nloc, unsigned& nx) {
    const unsigned G = gridDim.x * gridDim.y * gridDim.z;
    unsigned sum, cnt, mine, sp = 0u;
    for (;;) {
        sum = 0u; cnt = 0u; mine = 0u;
#pragma unroll
        for (unsigned j = 0; j < 16; ++j) { const unsigned c = xb_ld(&bar[XB_XCNT(j)]); sum += c; cnt += (c > 0u) ? 1u : 0u; mine = (j == x) ? c : mine; }
        if (sum == G) break;
        __builtin_amdgcn_s_sleep(1);
        if ((++sp & 255u) == 0u) { if (xb_ld(&bar[XB_TMO])) break; if (sp > XB_SPIN_CAP) { atomicAdd(&bar[XB_TMO], 1u); break; } }
    }
    nloc = mine > 0u ? mine : 1u; nx = cnt > 0u ? cnt : 1u;
}

__device__ __forceinline__ void xcd_barrier(const XcdBarrier& b) {
    asm volatile("s_waitcnt vmcnt(0)" ::: "memory");
    __syncthreads();
    if (threadIdx.x == 0) {
        unsigned* bar = b.bar;
        __builtin_amdgcn_s_waitcnt(0);
        unsigned nloc = b.st[0], nx = b.st[1];
        if (nloc == 0u) { xcd_barrier_complete(bar, b.x, nloc, nx); b.st[0] = nloc; b.st[1] = nx; }
        const unsigned old = xb_add(&bar[XB_XSUB(b.x)], 1u);
        const unsigned gen = old / nloc;
        if (old + 1u == (gen + 1u) * nloc) {
            __builtin_amdgcn_fence(__ATOMIC_RELEASE, "agent");
            asm volatile("s_waitcnt vmcnt(0)" ::: "memory");
            const unsigned og = xb_add(&bar[XB_TOP], 1u);
            const unsigned tg = og / nx;
            if (og + 1u == (tg + 1u) * nx) xb_add(&bar[XB_TOPGEN], 1u);
            else XB_SPIN(xb_ld(&bar[XB_TOPGEN]) == tg, bar);
            __builtin_amdgcn_fence(__ATOMIC_ACQUIRE, "agent");
            xb_add(&bar[XB_XGEN(b.x)], 1u);
            asm volatile("s_waitcnt vmcnt(0)" ::: "memory");
        } else {
            XB_SPIN(xb_ld(&bar[XB_XGEN(b.x)]) == gen, bar);
            __builtin_amdgcn_fence(__ATOMIC_ACQUIRE, "agent");
            asm volatile("s_waitcnt vmcnt(0)" ::: "memory");
        }
    }
    __syncthreads();
}

struct Args { const float* in[15]; float* out; unsigned char* ws; int ph_lo, ph_hi, li, pad; };
__global__ void __launch_bounds__(NWAVES * 64, 2) mega(Args a) {
    extern __shared__ __attribute__((aligned(16))) unsigned char lds_raw[];
    LAS unsigned char* lds = (LAS unsigned char*)lds_raw;
    const int tid = threadIdx.x, lane = tid & 63, wave = __builtin_amdgcn_readfirstlane(tid >> 6);
    const int G = gridDim.x, bx = blockIdx.x, vcu = (G % 8 == 0) ? (bx % 8) * (G / 8) + bx / 8 : bx;
    unsigned char* const ws = a.ws;
#define W1GU ((bf16*)(ws + WS_W1GU))
#define W1D ((bf16*)(ws + WS_W1D))
#define WIN ((bf16*)(ws + WS_WIN))
#define WBR ((bf16*)(ws + WS_WCOMB))
#define WOUT ((bf16*)(ws + WS_WOUT))
#define W2GU ((bf16*)(ws + WS_W2GU))
#define W2D ((bf16*)(ws + WS_W2D))
#define SSQ1 ((float*)(ws + WS_SSQ))
#define SSQ2 ((float*)(ws + WS_SSQ) + (size_t)T * 16)
#define SSQ0 ((float*)(ws + WS_SSQ) + (size_t)2 * T * 16)
#define HB ((bf16*)(ws + WS_HB))
#define ACT ((bf16*)(ws + WS_BIG))
#define P4 ((bf16*)(ws + WS_P4))
#define GR ((bf16*)(ws + WS_G))
#define GS ((bf16*)(ws + WS_G) + (size_t)T * 1024)
#define MB ((bf16*)(ws + WS_MB))
#define XP P4
#define QO (P4 + (size_t)T * 512)
#define KB (P4 + (size_t)2 * T * 512)
#define VB (P4 + (size_t)3 * T * 512)
#define H (a.out)
#define PO ((bf16*)(ws + WS_PO))
#define HB2 PO
#define OB (PO + 512)
    cg::grid_group grid = cg::this_grid();
    for (int u = tid; u < (LDS_BYTES - LDSCTL_OFF) / 4; u += NWAVES * 64) ((LAS unsigned*)(lds + LDSCTL_OFF))[u] = 0u;
    __syncthreads();
    const XcdBarrier bar = xcd_barrier_post((unsigned*)ws + CW_BAR + a.li * XCD_BAR_WORDS, (volatile LAS unsigned*)(lds + MISC_OFF) + 8);
    const int gwp = wave * G + vcu, NGW = G * NWAVES;

    const int lo = a.ph_lo, hi = a.ph_hi;
#define IN(k) ((PHASE_MASK >> (k)) & 1) && (lo <= (k) && (k) < hi)
#define SEAM(k) do { if ((k) + 1 < hi) { if (hi > NPHASE) grid.sync(); else { xcd_barrier(bar); if (PROBE_DOUBLE_SEAM) xcd_barrier(bar); } } } while (0)
    if (IN(0)) {
        LAS float* scr = (LAS float*)(lds + wave * 16384);
        for (int blk = bx; blk < 256; blk += G) comb_block(a.in[6], a.in[7], a.in[8], WBR, blk, lds, wave, lane, tid);
        constexpr int I_GU = (D / 64) * (2 * FF / 64), NITEMS = I_GU + T / 4;
        for (int it = gwp; it < NITEMS; it += NGW) {
            if (it < I_GU) tr_item(a.in[2], D, 2 * FF, W1GU, D, 0, a.in[1], FF, 0, it, scr, lane);
            else xb_rows4(a.in[0] + (size_t)(it - I_GU) * 4 * D, HB + (size_t)(it - I_GU) * 4 * D, SSQ0 + (size_t)(it - I_GU) * 4 * 16, lane);
        }
        SEAM(0);
    }
    if (IN(1)) {
        pg8::Gemm g{HB, W1GU, T, 2 * FF, D}; pg8::StaticOrder S; S.init(T, 2 * FF, G, bx);
        LAS float* rsl = (LAS float*)(lds + RSL_OFF); pg8::Unit u0{-1, 0}; S.next(0, u0);
        if (u0.pm >= 0) pg8::load_panel_rs(SSQ0, rsl, u0.pm); else __syncthreads();
        pg8::EpiSwiGLU E{ACT, SSQ0, FF, rsl, u0.pm};
        pg8::gemm_phase<pg8::EpiSwiGLU, pg8::StaticOrder, true, true>(lds, g, S, E);
        {
            constexpr int I_GU = (D / 64) * (2 * FF / 64), I_DN = (FF / 64) * (D / 64), I_IN = (D / 64) * (INW / 64), I_WA = (PW / 64) * (D / 64), I_WO = (D / 64) * (D / 64);
            constexpr int NIT = I_DN + I_WA + I_WO + I_IN + I_GU;
            const int rem = ((T / 256) * (2 * FF / 256)) % G, nidle = G - rem;
            if (bx >= rem) { LAS float* scr = (LAS float*)(lds + wave * 16384);
                for (int it = wave * nidle + (bx - rem); it < NIT; it += nidle * NWAVES) {
                    int r = it;
                    if (r < I_DN) { tr_item(a.in[3], FF, D, W1D, FF, 0, nullptr, 0, 0, r, scr, lane); continue; } r -= I_DN;
                    if (r < I_WA) { tr_item(a.in[9], PW, D, WBR, 1024, 512, nullptr, 0, 0, r, scr, lane); continue; } r -= I_WA;
                    if (r < I_WO) { tr_item(a.in[10], D, D, WOUT, D, 0, nullptr, 0, 0, r, scr, lane); continue; } r -= I_WO;
                    if (r < I_IN) { tr_item(a.in[5], D, INW, WIN, D, 0, a.in[4], 1024, 2048, r, scr, lane); continue; } r -= I_IN;
                    tr_item(a.in[12], D, 2 * FF, W2GU, D, 0, a.in[11], FF, 0, r, scr, lane); } }
        }
        SEAM(1);
    }
    if (IN(2)) {
        pg8::Gemm g{ACT, W1D, T, D, FF}; pg8::StaticOrder S; S.init(T, D, G, bx);
        pg8::EpiDown<false> E{nullptr, HB, HB, SSQ1, 0.5f};
        pg8::gemm_phase<pg8::EpiDown<false>, pg8::StaticOrder, true, true>(lds, g, S, E);
        SEAM(2);
    }
    if (IN(3)) {
        pg8::Gemm g{HB, WIN, T, INW, D}; pg8::StaticOrder S; S.init(T, INW, G, bx);
        LAS float* rsl = (LAS float*)(lds + RSL_OFF); pg8::Unit u0{-1, 0}; S.next(0, u0);
        if (u0.pm >= 0) pg8::load_panel_rs(SSQ1, rsl, u0.pm); else __syncthreads();
        pg8::EpiWin E{P4, GR, GS, SSQ1, rsl, u0.pm};
        pg8::gemm_phase<pg8::EpiWin, pg8::StaticOrder, true, true>(lds, g, S, E);
        SEAM(3);
    }
    if (IN(4)) {
#pragma nounroll
        for (int rep_ = 0; rep_ < 1 + PROBE_ATTN2; ++rep_)
        if (G == 256) {
            const int x = bx & 7, wq = (bx >> 3) * 8 + wave;
            sb::attn_wave2(8 * x + (wq >> 5), wq & 31, QO, KB, VB, OB, lane);
        } else for (int w = gwp; w < 2048; w += NGW) sb::attn_wave2(w >> 5, w & 31, QO, KB, VB, OB, lane);
#pragma nounroll
        for (int rep_ = 0; rep_ < 1 + PROBE_POOL2; ++rep_)
        pool_phase(XP, PO, gwp, NGW, lane);
        SEAM(4);
    }
    if (IN(5)) {
        pg8::Gemm g{PO, WBR, T, D, D}; pg8::StaticOrder S; S.init(T, D, G, bx);
        pg8::EpiBranchF E{MB, GR, GS};
        pg8::gemm_phase<pg8::EpiBranchF, pg8::StaticOrder, true, true>(lds, g, S, E);
        SEAM(5);
    }
    if (IN(6)) {
        pg8::Gemm g{MB, WOUT, T, D, D}; pg8::StaticOrder S; S.init(T, D, G, bx);
        pg8::EpiDown<false> E{nullptr, HB, HB2, SSQ2, 1.0f};
        pg8::gemm_phase<pg8::EpiDown<false>, pg8::StaticOrder, true, true>(lds, g, S, E);
        SEAM(6);
    }
    if (IN(7)) {
        pg8::Gemm g{HB2, W2GU, T, 2 * FF, D}; pg8::StaticOrder S; S.init(T, 2 * FF, G, bx);
        LAS float* rsl = (LAS float*)(lds + RSL_OFF); pg8::Unit u0{-1, 0}; S.next(0, u0);
        if (u0.pm >= 0) pg8::load_panel_rs(SSQ2, rsl, u0.pm); else __syncthreads();
        pg8::EpiSwiGLU E{ACT, SSQ2, FF, rsl, u0.pm};
        pg8::gemm_phase<pg8::EpiSwiGLU, pg8::StaticOrder, true, true>(lds, g, S, E);
        {
            constexpr int I_DN = (FF / 64) * (D / 64);
            const int rem = ((T / 256) * (2 * FF / 256)) % G, nidle = G - rem;
            if (bx >= rem) { LAS float* scr = (LAS float*)(lds + wave * 16384);
                for (int it = wave * nidle + (bx - rem); it < I_DN; it += nidle * NWAVES) tr_item(a.in[13], FF, D, W2D, FF, 0, nullptr, 0, 0, it, scr, lane); }
        }
        SEAM(7);
    }
    const bool fuse_final = (G == 256) && (lo <= 8) && (hi >= 10);
    if (IN(8)) {
        pg8::Gemm g{ACT, W2D, T, D, FF}; pg8::StaticOrder S; S.init(T, D, G, bx);
        if (fuse_final) {
            pg8::EpiDownFinal E{HB2, H, a.in[14], SSQ1, (unsigned*)ws + CW_CNT, 0.5f};
            pg8::gemm_phase<pg8::EpiDownFinal, pg8::StaticOrder, true, true>(lds, g, S, E);
        } else {
            pg8::EpiDownF32 E{HB2, H, 0.5f};
            pg8::gemm_phase<pg8::EpiDownF32, pg8::StaticOrder, true, true>(lds, g, S, E);
            SEAM(8);
        }
    }
    if (IN(9) && !fuse_final) {
        for (int r = gwp; r < T; r += NGW) rms_row_f32(H + (size_t)r * D, a.in[14], lane);
    }
#undef IN
#undef SEAM
}

#undef W1GU
#undef W1D
#undef WIN
#undef WBR
#undef WOUT
#undef W2GU
#undef W2D
#undef SSQ1
#undef SSQ2
#undef SSQ0
#undef HB
#undef ACT
#undef P4
#undef GR
#undef GS
#undef MB
#undef XP
#undef QO
#undef KB
#undef VB
#undef H
#undef OB
#undef PO
#undef HB2

extern "C" void kernel_launch(void* const* d_in, const int* in_sizes, int n_in, void* d_out, int out_size, void* d_ws, size_t ws_size, hipStream_t stream) {
    static int grid = 0;
    if (grid == 0) {
        if (n_in != 15 || in_sizes[0] != T * D || out_size != T * D || ws_size < WS_END) { fprintf(stderr, "kernel_launch: unexpected shapes (n_in %d, in0 %d, out %d, ws %zu); nothing launched\n", n_in, n_in > 0 ? in_sizes[0] : -1, out_size, ws_size); grid = -1; return; }
        int dev = 0, cus = 0, per_cu = 0;
        if (hipGetDevice(&dev) != hipSuccess || hipDeviceGetAttribute(&cus, hipDeviceAttributeMultiprocessorCount, dev) != hipSuccess) { grid = -1; return; }
        if (hipFuncSetAttribute((const void*)mega, hipFuncAttributeMaxDynamicSharedMemorySize, LDS_BYTES) != hipSuccess) { fprintf(stderr, "kernel_launch: hipFuncSetAttribute failed\n"); grid = -1; return; }
        if (hipOccupancyMaxActiveBlocksPerMultiprocessor(&per_cu, (const void*)mega, NWAVES * 64, LDS_BYTES) != hipSuccess || per_cu < 1) { fprintf(stderr, "kernel_launch: occupancy query says %d per CU; using 1\n", per_cu); per_cu = 1; }
        (void)hipGetLastError();
        grid = cus * per_cu;
        if (grid > 256 && grid % 8) grid -= grid % 8;
    }
    if (grid < 0) return;
    Args a{};
    for (int i = 0; i < 15; ++i) a.in[i] = (const float*)d_in[i];
    a.out = (float*)d_out; a.ws = (unsigned char*)d_ws;
#if DEBUG_MODE == 0
    if (hipMemsetAsync(d_ws, 0, CTL_ZERO_BYTES, stream) != hipSuccess) { fprintf(stderr, "kernel_launch: hipMemsetAsync failed\n"); return; }
    void* args[] = {&a};
    const int cut = PROBE_REPEAT >= 0 ? PROBE_REPEAT + 1 : (PROBE_SPLIT >= 0 ? PROBE_SPLIT + 1 : NPHASE);
    a.ph_lo = 0; a.ph_hi = cut; a.li = 0;
    hipError_t e = hipLaunchCooperativeKernel((const void*)mega, dim3(grid), dim3(NWAVES * 64), args, LDS_BYTES, stream);
    if (e == hipSuccess && cut < NPHASE) { a.ph_lo = PROBE_REPEAT >= 0 ? PROBE_REPEAT : cut; a.ph_hi = NPHASE; a.li = 1;
        e = hipLaunchCooperativeKernel((const void*)mega, dim3(grid), dim3(NWAVES * 64), args, LDS_BYTES, stream); }
    if (e != hipSuccess) fprintf(stderr, "kernel_launch: cooperative launch failed: %s (grid %d)\n", hipGetErrorString(e), grid);
#else
    for (int ph = 0; ph < NPHASE; ++ph) {
        a.ph_lo = ph; a.ph_hi = ph + 1;
        hipLaunchKernelGGL(mega, dim3(grid), dim3(NWAVES * 64), LDS_BYTES, stream, a);
    }
#endif
}
```

```cpp
#include <hip/hip_runtime.h>
#include <hip/hip_cooperative_groups.h>
#include <cstdio>
#include <cstdint>
namespace cg = cooperative_groups;
#ifndef DEBUG_MODE
#define DEBUG_MODE 0
#endif
namespace pg8 {
#define PG8_LAS __attribute__((address_space(3)))
typedef unsigned short bf16_t;
typedef short bf16x8 __attribute__((ext_vector_type(8)));
typedef float f32x4 __attribute__((ext_vector_type(4)));
typedef unsigned u32x4 __attribute__((ext_vector_type(4)));
constexpr int BM = 256, BK = 64, HALF = 128, HTB = HALF * BK * 2  , STAGE_BYTES = 8 * HTB, NXCD = 8, WGM = 8;

__host__ __device__ __forceinline__ int lds_byte(int r, int c) { const int st = (r >> 4) * 2 + (c >> 5), rr = r & 15, cc = c & 31, ob = rr * 64 + cc * 2; return st * 1024 + (ob ^ (((ob >> 9) & 1) << 5)); }
__host__ __device__ __forceinline__ void stage_rc(int b, int& R, int& C) { const int st = b / 1024, sb = b % 1024, swz = sb ^ (((sb >> 9) & 1) << 5); R = (st >> 1) * 16 + swz / 64; C = (st & 1) * 32 + (swz % 64) / 2; }
__host__ __device__ __forceinline__ int perm32(int rho) { const int n = rho >> 4, i = rho & 15; return 8 * (i >> 2) + 4 * n + (i & 3); }

struct Unit { int pm, pn; };
struct Gemm { const bf16_t* A; const bf16_t* Bt; int M, N, K; };

struct StaticOrder {
    int nM, nN, nwg, G, c;
    __host__ __device__ void init(int M, int N, int G_, int c_) { nM = M / BM; nN = N / BM; nwg = nM * nN; G = G_; c = c_; }
    __host__ __device__ bool next(int i, Unit& u) const {
        const long L = (long)i * G + c; if (L >= nwg) return false;
        int wgid = (int)L; { const int q = nwg / NXCD, r = nwg % NXCD, xcd = wgid % NXCD, off = wgid / NXCD; wgid = (xcd < r ? xcd * (q + 1) : r * (q + 1) + (xcd - r) * q) + off; }
        const int nig = WGM * nN, gid = wgid / nig, fm = gid * WGM, gsz = (nM - fm) < WGM ? (nM - fm) : WGM;
        u.pm = fm + ((wgid % nig) % gsz); u.pn = (wgid % nig) / gsz; return true;
    }
    __device__ __forceinline__ void a_ready(const Unit&) const {}
    __device__ __forceinline__ void done(const Unit&) const {}
};

__device__ __forceinline__ unsigned cvt_pk_bf16(float lo, float hi) { unsigned r; asm volatile("v_cvt_pk_bf16_f32 %0, %1, %2" : "=v"(r) : "v"(lo), "v"(hi)); return r; }
typedef float f32x2 __attribute__((ext_vector_type(2)));
constexpr float RMS_EPS_F = 1e-6f, LOG2E_F = 1.4426950408889634f;
__device__ __forceinline__ float row_rs(const float* ssq, int row) {
    const f32x4* p = (const f32x4*)(ssq + (size_t)row * 16);
    const f32x4 a = p[0], b = p[1], c = p[2], d = p[3];
    const float s = (((a[0] + a[1]) + (a[2] + a[3])) + ((b[0] + b[1]) + (b[2] + b[3]))) + (((c[0] + c[1]) + (c[2] + c[3])) + ((d[0] + d[1]) + (d[2] + d[3])));
    return __builtin_amdgcn_rsqf(s * (1.0f / 1024.0f) + RMS_EPS_F);
}
__device__ __forceinline__ void rows_rs(const float* ssq, int row0, int fq, float (&rs)[2][4]) {
    f32x4 q[2][4];
#pragma unroll
    for (int ai = 0; ai < 2; ++ai)
#pragma unroll
        for (int m = 0; m < 4; ++m) q[ai][m] = *(const f32x4*)(ssq + (size_t)(row0 + ai * HALF + m * 16) * 16 + 4 * fq);
#pragma unroll
    for (int ai = 0; ai < 2; ++ai)
#pragma unroll
        for (int m = 0; m < 4; ++m) { float s = (q[ai][m][0] + q[ai][m][1]) + (q[ai][m][2] + q[ai][m][3]); s += __shfl_xor(s, 16); s += __shfl_xor(s, 32); rs[ai][m] = __builtin_amdgcn_rsqf(s * (1.0f / 1024.0f) + RMS_EPS_F); }
}
__device__ __forceinline__ void unit_rs(const float* ssq, const PG8_LAS float* rsl, int pm0, const Unit& u, int wr, int fr, int fq, float (&rs)[2][4]) {
    if (u.pm == pm0) {
#pragma unroll
        for (int ai = 0; ai < 2; ++ai)
#pragma unroll
            for (int m = 0; m < 4; ++m) rs[ai][m] = rsl[ai * HALF + wr * 64 + m * 16 + fr];
    } else rows_rs(ssq, u.pm * BM + wr * 64 + fr, fq, rs);
}
__device__ __forceinline__ void load_panel_rs(const float* ssq, PG8_LAS float* rsl, int pm0) {
    const int t = threadIdx.x;
    if (t < 256) rsl[t] = row_rs(ssq, pm0 * BM + t);
    __syncthreads();
}
__device__ __forceinline__ float sigmoid_f(float v) { return __builtin_amdgcn_rcpf(1.0f + __builtin_amdgcn_exp2f(-v * LOG2E_F)); }
__device__ __forceinline__ float bflo(unsigned w) { return __builtin_bit_cast(float, w << 16); }
__device__ __forceinline__ float bfhi(unsigned w) { return __builtin_bit_cast(float, w & 0xffff0000u); }

struct EpiSwiGLU {
    static constexpr bool PERM = true, AFTER_DRAIN = false, MID = false;
    bf16_t* O; const float* ssq; int ldo; const PG8_LAS float* rsl; int pm0;
    __device__ __forceinline__ void operator()(const f32x4 (&acc)[2][2][4][2], const Unit& u, int wr, int wc, int fr, int fq) const {
        const int row0 = u.pm * BM + wr * 64 + fr, col0 = u.pn * HALF + wc * 32 + 8 * fq;
        float rsv[2][4] = {{1.f, 1.f, 1.f, 1.f}, {1.f, 1.f, 1.f, 1.f}};
        if (ssq) unit_rs(ssq, rsl, pm0, u, wr, fr, fq, rsv);
#pragma unroll
        for (int ai = 0; ai < 2; ++ai)
#pragma unroll
            for (int m = 0; m < 4; ++m) {
                const int row = row0 + ai * HALF + m * 16;
                const float rs = rsv[ai][m];
                float o[8];
                const float nrl = -rs * LOG2E_F, rs2 = rs * rs;
#pragma unroll
                for (int n = 0; n < 2; ++n)
#pragma unroll
                    for (int h = 0; h < 2; ++h) {
                        const f32x2 g = {acc[ai][0][m][n][2 * h], acc[ai][0][m][n][2 * h + 1]}, uu = {acc[ai][1][m][n][2 * h], acc[ai][1][m][n][2 * h + 1]};
                        const f32x2 t = g * nrl; f32x2 ex; ex.x = __builtin_amdgcn_exp2f(t.x); ex.y = __builtin_amdgcn_exp2f(t.y);
                        const f32x2 d = ex + 1.0f; f32x2 r; r.x = __builtin_amdgcn_rcpf(d.x); r.y = __builtin_amdgcn_rcpf(d.y);
                        const f32x2 p = ((g * uu) * rs2) * r;
                        o[4 * n + 2 * h] = p.x; o[4 * n + 2 * h + 1] = p.y;
                    }
                u32x4 w; w.x = cvt_pk_bf16(o[0], o[1]); w.y = cvt_pk_bf16(o[2], o[3]); w.z = cvt_pk_bf16(o[4], o[5]); w.w = cvt_pk_bf16(o[6], o[7]);
                *(u32x4*)(O + (size_t)row * ldo + col0) = w;
            }
    }
};
template <bool F32BASE> struct EpiDown {
    static constexpr bool PERM = true, AFTER_DRAIN = false, MID = false;
    const float* basef; const bf16_t* baseh; bf16_t* HB; float* ssq; float alpha;
    __device__ __forceinline__ void operator()(const f32x4 (&acc)[2][2][4][2], const Unit& u, int wr, int wc, int fr, int fq) const {
        const int row0 = u.pm * BM + wr * 64 + fr, col0 = u.pn * BM + wc * 32 + 8 * fq;
        u32x4 bh[F32BASE ? 1 : 2][4][2];
        if constexpr (!F32BASE) {
#pragma unroll
            for (int ai = 0; ai < 2; ++ai)
#pragma unroll
                for (int m = 0; m < 4; ++m)
#pragma unroll
                    for (int bj = 0; bj < 2; ++bj) bh[ai][m][bj] = *(const u32x4*)(baseh + (size_t)(row0 + ai * HALF + m * 16) * 1024 + col0 + bj * HALF);
        }
#pragma unroll
        for (int ai = 0; ai < 2; ++ai) {
            f32x4 bf[F32BASE ? 4 : 1][2][2];
            if constexpr (F32BASE) {
#pragma unroll
                for (int m = 0; m < 4; ++m)
#pragma unroll
                    for (int bj = 0; bj < 2; ++bj) { const size_t off = (size_t)(row0 + ai * HALF + m * 16) * 1024 + col0 + bj * HALF;
                        bf[m][bj][0] = *(const f32x4*)(basef + off); bf[m][bj][1] = *(const f32x4*)(basef + off + 4); }
            }
#pragma unroll
            for (int m = 0; m < 4; ++m) {
                const int row = row0 + ai * HALF + m * 16; float s = 0.f;
#pragma unroll
                for (int bj = 0; bj < 2; ++bj) {
                    const size_t off = (size_t)row * 1024 + col0 + bj * HALF;
                    f32x4 b0, b1;
                    if constexpr (F32BASE) { b0 = bf[m][bj][0]; b1 = bf[m][bj][1]; }
                    else { const u32x4 bw = bh[ai][m][bj]; b0 = (f32x4){bflo(bw.x), bfhi(bw.x), bflo(bw.y), bfhi(bw.y)}; b1 = (f32x4){bflo(bw.z), bfhi(bw.z), bflo(bw.w), bfhi(bw.w)}; }
                    const f32x4 h0 = b0 + acc[ai][bj][m][0] * alpha, h1 = b1 + acc[ai][bj][m][1] * alpha;
                    u32x4 w; w.x = cvt_pk_bf16(h0[0], h0[1]); w.y = cvt_pk_bf16(h0[2], h0[3]); w.z = cvt_pk_bf16(h1[0], h1[1]); w.w = cvt_pk_bf16(h1[2], h1[3]); *(u32x4*)(HB + off) = w;
                    s += ((h0[0] * h0[0] + h0[1] * h0[1]) + (h0[2] * h0[2] + h0[3] * h0[3])) + ((h1[0] * h1[0] + h1[1] * h1[1]) + (h1[2] * h1[2] + h1[3] * h1[3]));
                }
                s += __shfl_xor(s, 16); s += __shfl_xor(s, 32); if (fq == 0) ssq[(size_t)row * 16 + u.pn * 4 + wc] = s;
            }
        }
    }
};
struct EpiWin {
    static constexpr bool PERM = true, AFTER_DRAIN = false, MID = false;
    bf16_t* P4; bf16_t* GR; bf16_t* GS; const float* ssq; const PG8_LAS float* rsl; int pm0;
    __device__ __forceinline__ void operator()(const f32x4 (&acc)[2][2][4][2], const Unit& u, int wr, int wc, int fr, int fq) const {
        const int pn = u.pn; const bool gate = pn >= 8;
        const int row0 = u.pm * BM + wr * 64 + fr;
        float rsv[2][4]; unit_rs(ssq, rsl, pm0, u, wr, fr, fq, rsv);
        if (!gate) {
            bf16_t* basep = P4 + (size_t)(pn >> 1) * ((size_t)16384 * 512);
            const float qs = ((pn >> 1) == 1) ? 0.125f * LOG2E_F : 1.0f;
            const int col0 = (pn & 1) * 256 + wc * 32 + 8 * fq;
#pragma unroll
            for (int ai = 0; ai < 2; ++ai)
#pragma unroll
                for (int m = 0; m < 4; ++m) {
                    const int row = row0 + ai * HALF + m * 16;
                    const float rs = rsv[ai][m] * qs;
#pragma unroll
                    for (int bj = 0; bj < 2; ++bj) {
                        const f32x4 v0 = acc[ai][bj][m][0] * rs, v1 = acc[ai][bj][m][1] * rs;
                        u32x4 w; w.x = cvt_pk_bf16(v0[0], v0[1]); w.y = cvt_pk_bf16(v0[2], v0[3]); w.z = cvt_pk_bf16(v1[0], v1[1]); w.w = cvt_pk_bf16(v1[2], v1[3]);
                        if ((pn >> 1) == 3) {
                            const int c = col0 + bj * HALF, hh = c >> 6, d0 = c & 63, bb = row >> 11, tt = row & 2047;
                            bf16_t* vt = basep + ((size_t)((bb * 8 + hh) * 64 + d0)) * 2048 + tt;
                            vt[0 * 2048] = (bf16_t)(w.x & 0xffffu); vt[1 * 2048] = (bf16_t)(w.x >> 16); vt[2 * 2048] = (bf16_t)(w.y & 0xffffu); vt[3 * 2048] = (bf16_t)(w.y >> 16);
                            vt[4 * 2048] = (bf16_t)(w.z & 0xffffu); vt[5 * 2048] = (bf16_t)(w.z >> 16); vt[6 * 2048] = (bf16_t)(w.w & 0xffffu); vt[7 * 2048] = (bf16_t)(w.w >> 16);
                        } else *(u32x4*)(basep + (size_t)row * 512 + col0 + bj * HALF) = w;
                    }
                }
        } else {
            const int col0 = (pn - 8) * HALF + wc * 32 + 8 * fq;
#pragma unroll
            for (int ai = 0; ai < 2; ++ai)
#pragma unroll
                for (int m = 0; m < 4; ++m) {
                    const int row = row0 + ai * HALF + m * 16;
                    const float rs = rsv[ai][m];
                    float r8[8], s8[8];
#pragma unroll
                    for (int n = 0; n < 2; ++n)
#pragma unroll
                        for (int e = 0; e < 4; ++e) { const float ea = __builtin_amdgcn_exp2f(acc[ai][0][m][n][e] * (-rs * LOG2E_F)), eb = __builtin_fminf(__builtin_amdgcn_exp2f(acc[ai][1][m][n][e] * (-rs * LOG2E_F)), 1e18f);
                            const float opb = 1.0f + eb;
                            s8[4 * n + e] = __builtin_amdgcn_rcpf(opb); r8[4 * n + e] = opb * __builtin_amdgcn_rcpf(1.0f + ea); }
                    u32x4 w; w.x = cvt_pk_bf16(r8[0], r8[1]); w.y = cvt_pk_bf16(r8[2], r8[3]); w.z = cvt_pk_bf16(r8[4], r8[5]); w.w = cvt_pk_bf16(r8[6], r8[7]);
                    *(u32x4*)(GR + (size_t)row * 1024 + col0) = w;
                    w.x = cvt_pk_bf16(s8[0], s8[1]); w.y = cvt_pk_bf16(s8[2], s8[3]); w.z = cvt_pk_bf16(s8[4], s8[5]); w.w = cvt_pk_bf16(s8[6], s8[7]);
                    *(u32x4*)(GS + (size_t)row * 1024 + col0) = w;
                }
        }
    }
};
struct EpiBranchF {
    static constexpr bool PERM = true, AFTER_DRAIN = false, MID = true;
    bf16_t* Mb; const bf16_t* GR; const bf16_t* GS;
    __device__ __forceinline__ void mid(f32x4 (&acc)[2][2][4][2], const Unit& u, int wr, int wc, int fr, int fq) const {
        int row0 = u.pm * BM + wr * 64 + fr; const int col0 = u.pn * BM + wc * 32 + 8 * fq;
        asm volatile("" : "+v"(row0));
#pragma unroll
        for (int ai = 0; ai < 2; ++ai) {
            u32x4 gw[4][2];
#pragma unroll
            for (int m = 0; m < 4; ++m)
#pragma unroll
                for (int bj = 0; bj < 2; ++bj) gw[m][bj] = *(const u32x4*)(GR + (size_t)(row0 + ai * HALF + m * 16) * 1024 + col0 + bj * HALF);
#pragma unroll
            for (int m = 0; m < 4; ++m)
#pragma unroll
                for (int bj = 0; bj < 2; ++bj) { const u32x4 w = gw[m][bj]; f32x4& v0 = acc[ai][bj][m][0]; f32x4& v1 = acc[ai][bj][m][1];
                    v0[0] *= bflo(w.x); v0[1] *= bfhi(w.x); v0[2] *= bflo(w.y); v0[3] *= bfhi(w.y); v1[0] *= bflo(w.z); v1[1] *= bfhi(w.z); v1[2] *= bflo(w.w); v1[3] *= bfhi(w.w); }
            asm volatile("" ::: "memory");
        }
    }
    __device__ __forceinline__ void operator()(const f32x4 (&acc)[2][2][4][2], const Unit& u, int wr, int wc, int fr, int fq) const {
        const int row0 = u.pm * BM + wr * 64 + fr, col0 = u.pn * BM + wc * 32 + 8 * fq;
        u32x4 gwv[2][4][2];
#pragma unroll
        for (int ai = 0; ai < 2; ++ai)
#pragma unroll
            for (int m = 0; m < 4; ++m)
#pragma unroll
                for (int bj = 0; bj < 2; ++bj) gwv[ai][m][bj] = *(const u32x4*)(GS + (size_t)(row0 + ai * HALF + m * 16) * 1024 + col0 + bj * HALF);
#pragma unroll
        for (int ai = 0; ai < 2; ++ai)
#pragma unroll
            for (int m = 0; m < 4; ++m)
#pragma unroll
                for (int bj = 0; bj < 2; ++bj) {
                    const size_t off = (size_t)(row0 + ai * HALF + m * 16) * 1024 + col0 + bj * HALF;
                    const u32x4 gw = gwv[ai][m][bj];
                    f32x4 v0 = acc[ai][bj][m][0], v1 = acc[ai][bj][m][1];
                    v0[0] *= bflo(gw.x); v0[1] *= bfhi(gw.x); v0[2] *= bflo(gw.y); v0[3] *= bfhi(gw.y); v1[0] *= bflo(gw.z); v1[1] *= bfhi(gw.z); v1[2] *= bflo(gw.w); v1[3] *= bfhi(gw.w);
                    u32x4 w; w.x = cvt_pk_bf16(v0[0], v0[1]); w.y = cvt_pk_bf16(v0[2], v0[3]); w.z = cvt_pk_bf16(v1[0], v1[1]); w.w = cvt_pk_bf16(v1[2], v1[3]);
                    *(u32x4*)(Mb + off) = w;
                }
    }
};
struct EpiDownFinal {
    static constexpr bool PERM = true, AFTER_DRAIN = true, MID = false;
    const bf16_t* base; float* out; const float* gain; float* xbuf; unsigned* cnt; float alpha;
    __device__ __forceinline__ void fused(f32x4 (&acc)[2][2][4][2], const Unit& u, int wr, int wc, int fr, int fq, PG8_LAS unsigned char* lds, int wid, int lane) const {
        PG8_LAS float* P = (PG8_LAS float*)lds;
        PG8_LAS float* S = (PG8_LAS float*)(lds + 4096);
        const int row0 = u.pm * BM + wr * 64 + fr, col0 = u.pn * BM + wc * 32 + 8 * fq;
        u32x4 bwv[2][4][2];
#pragma unroll
        for (int ai = 0; ai < 2; ++ai)
#pragma unroll
            for (int m = 0; m < 4; ++m)
#pragma unroll
                for (int bj = 0; bj < 2; ++bj) bwv[ai][m][bj] = *(const u32x4*)(base + (size_t)(row0 + ai * HALF + m * 16) * 1024 + col0 + bj * HALF);
#pragma unroll
        for (int ai = 0; ai < 2; ++ai)
#pragma unroll
            for (int m = 0; m < 4; ++m) {
                float s = 0.f;
#pragma unroll
                for (int bj = 0; bj < 2; ++bj) {
                    const u32x4 bw = bwv[ai][m][bj];
                    const f32x4 b0 = (f32x4){bflo(bw.x), bfhi(bw.x), bflo(bw.y), bfhi(bw.y)}, b1 = (f32x4){bflo(bw.z), bfhi(bw.z), bflo(bw.w), bfhi(bw.w)};
                    const f32x4 h0 = b0 + acc[ai][bj][m][0] * alpha, h1 = b1 + acc[ai][bj][m][1] * alpha;
                    acc[ai][bj][m][0] = h0; acc[ai][bj][m][1] = h1;
                    s += ((h0[0] * h0[0] + h0[1] * h0[1]) + (h0[2] * h0[2] + h0[3] * h0[3])) + ((h1[0] * h1[0] + h1[1] * h1[1]) + (h1[2] * h1[2] + h1[3] * h1[3]));
                }
                s += __shfl_xor(s, 16); s += __shfl_xor(s, 32);
                if (fq == 0) P[(ai * HALF + wr * 64 + m * 16 + fr) * 4 + wc] = s;
            }
        asm volatile("s_waitcnt lgkmcnt(0)" ::: "memory"); __builtin_amdgcn_s_barrier(); asm volatile("" ::: "memory");
        const int row = wid * 32 + (lane & 31);
        if (lane < 32) { const float t = (P[row * 4 + 0] + P[row * 4 + 1]) + (P[row * 4 + 2] + P[row * 4 + 3]);
            __hip_atomic_store(xbuf + (size_t)(u.pm * BM + row) * 4 + u.pn, t, __ATOMIC_RELAXED, __HIP_MEMORY_SCOPE_AGENT); }
        asm volatile("s_waitcnt vmcnt(0)" ::: "memory");
        if (lane == 0) __hip_atomic_fetch_add(cnt + 64 * u.pm, 1u, __ATOMIC_RELAXED, __HIP_MEMORY_SCOPE_AGENT);
        if (wid == 0) {
            unsigned sp = 0;
            while ((unsigned)__builtin_amdgcn_readfirstlane(__hip_atomic_load(cnt + 64 * u.pm, __ATOMIC_RELAXED, __HIP_MEMORY_SCOPE_AGENT)) < 32u) { __builtin_amdgcn_s_sleep(2); if (++sp > (1u << 20)) break; }
            __builtin_amdgcn_fence(__ATOMIC_ACQUIRE, "agent");
        }
        asm volatile("s_waitcnt vmcnt(0) lgkmcnt(0)" ::: "memory"); __builtin_amdgcn_s_barrier(); asm volatile("" ::: "memory");
        if (lane < 32) { const float* slot = xbuf + (size_t)(u.pm * BM + row) * 4; float t = 0.f;
#pragma unroll
            for (int k = 0; k < 4; ++k) t += __hip_atomic_load(slot + k, __ATOMIC_RELAXED, __HIP_MEMORY_SCOPE_AGENT);
            S[row] = __builtin_amdgcn_rsqf(t * (1.0f / 1024.0f) + RMS_EPS_F); }
        asm volatile("s_waitcnt lgkmcnt(0)" ::: "memory"); __builtin_amdgcn_s_barrier(); asm volatile("" ::: "memory");
#pragma unroll
        for (int bj = 0; bj < 2; ++bj) {
            const f32x4 g0 = *(const f32x4*)(gain + col0 + bj * HALF), g1 = *(const f32x4*)(gain + col0 + bj * HALF + 4);
#pragma unroll
            for (int ai = 0; ai < 2; ++ai)
#pragma unroll
                for (int m = 0; m < 4; ++m) {
                    const int r = ai * HALF + wr * 64 + m * 16 + fr; const float rs = S[r];
                    const size_t off = (size_t)(u.pm * BM + r) * 1024 + col0 + bj * HALF;
                    *(f32x4*)(out + off) = acc[ai][bj][m][0] * rs * g0; *(f32x4*)(out + off + 4) = acc[ai][bj][m][1] * rs * g1;
                }
        }
    }
};

struct EpiDownF32 {
    static constexpr bool PERM = true, AFTER_DRAIN = false, MID = false;
    const bf16_t* base; float* out; float alpha;
    __device__ __forceinline__ void operator()(const f32x4 (&acc)[2][2][4][2], const Unit& u, int wr, int wc, int fr, int fq) const {
        const int row0 = u.pm * BM + wr * 64 + fr, col0 = u.pn * BM + wc * 32 + 8 * fq;
#pragma unroll
        for (int ai = 0; ai < 2; ++ai)
#pragma unroll
            for (int m = 0; m < 4; ++m)
#pragma unroll
                for (int bj = 0; bj < 2; ++bj) {
                    const size_t off = (size_t)(row0 + ai * HALF + m * 16) * 1024 + col0 + bj * HALF;
                    const u32x4 bw = *(const u32x4*)(base + off);
                    const f32x4 b0 = (f32x4){bflo(bw.x), bfhi(bw.x), bflo(bw.y), bfhi(bw.y)}, b1 = (f32x4){bflo(bw.z), bfhi(bw.z), bflo(bw.w), bfhi(bw.w)};
                    *(f32x4*)(out + off) = b0 + acc[ai][bj][m][0] * alpha; *(f32x4*)(out + off + 4) = b1 + acc[ai][bj][m][1] * alpha;
                }
    }
};
template <class Epi, class Sched, bool ALIGN_EPI = false, bool SP2 = false>
__device__ __forceinline__ void gemm_phase(PG8_LAS unsigned char* lds, const Gemm g, const Sched& S, const Epi& E) {
    const int tid = threadIdx.x, wid = __builtin_amdgcn_readfirstlane(tid >> 6), lane = tid & 63, wr = wid >> 2, wc = wid & 3, fr = lane & 15, fq = lane >> 4;
    const int K = g.K, nt = K / BK;
    unsigned voffA[2], voffB[2];
#pragma unroll
    for (int i = 0; i < 2; ++i) { int R, C; stage_rc(tid * 16 + i * 8192, R, C); const int Rb = Epi::PERM ? ((R & ~31) + perm32(R & 31)) : R;
        voffA[i] = (unsigned)(R * K + C) * 2u; voffB[i] = (unsigned)(Rb * K + C) * 2u; }
    const size_t kstep = (size_t)(BK * 2);
    const size_t hstep = (size_t)HALF * K * 2;
    const size_t tstep = 2 * hstep;
    const unsigned ldsw = (unsigned)wid * 1024u;
    const int aoff = lds_byte(wr * 64 + fr, fq * 8), boff = lds_byte(wc * 32 + fr, fq * 8);
#define PG8_SA(b, h) (((b) * 2 + (h)) * HTB)
#define PG8_SB(b, h) ((4 + (b) * 2 + (h)) * HTB)
#define PG8_STAGE(bufoff, gbase, voff) do { _Pragma("unroll") for (int _i = 0; _i < 2; ++_i) \
        __builtin_amdgcn_global_load_lds((const unsigned*)((const char*)(gbase) + (voff)[_i]), (PG8_LAS unsigned*)(lds + (bufoff) + ldsw + _i * 8192), 16, 0, 0); } while (0)
#define PG8_LDA(dst, b, h) do { _Pragma("unroll") for (int m = 0; m < 4; ++m) _Pragma("unroll") for (int k = 0; k < 2; ++k) dst[m][k] = *(const PG8_LAS bf16x8*)(lds + PG8_SA(b, h) + aoff + m * 2048 + k * 1024); } while (0)
#define PG8_LDB(dst, b, h) do { _Pragma("unroll") for (int n = 0; n < 2; ++n) _Pragma("unroll") for (int k = 0; k < 2; ++k) dst[n][k] = *(const PG8_LAS bf16x8*)(lds + PG8_SB(b, h) + boff + n * 2048 + k * 1024); } while (0)
#define PG8_MMA(ai, bj, At, Bt) do { __builtin_amdgcn_s_setprio(1); _Pragma("unroll") for (int m = 0; m < 4; ++m) _Pragma("unroll") for (int n = 0; n < 2; ++n) _Pragma("unroll") for (int k = 0; k < 2; ++k) \
        acc[ai][bj][m][n] = __builtin_amdgcn_mfma_f32_16x16x32_bf16(Bt[n][k], At[m][k], acc[ai][bj][m][n], 0, 0, 0); __builtin_amdgcn_s_setprio(0); } while (0)
#define PG8_WAIT_V(n) asm volatile("s_waitcnt vmcnt(" #n ")" ::: "memory")
#define PG8_WAIT_L(n) asm volatile("s_waitcnt lgkmcnt(" #n ")" ::: "memory")
#define PG8_BAR __builtin_amdgcn_s_barrier()
#define PG8_SCHED __builtin_amdgcn_sched_barrier(0)
    Unit cur, nxt; int ui = 0;
    if (!S.next(0, cur)) return;
    f32x4 acc[2][2][4][2];
#pragma unroll
    for (int a = 0; a < 2; ++a)
#pragma unroll
        for (int b = 0; b < 2; ++b)
#pragma unroll
            for (int m = 0; m < 4; ++m)
#pragma unroll
                for (int n = 0; n < 2; ++n) acc[a][b][m][n] = (f32x4){0.f, 0.f, 0.f, 0.f};
    bf16x8 At[4][2], B0[2][2], B1[2][2];
    const char* cA = (const char*)g.A + (size_t)cur.pm * tstep; const char* cB = (const char*)g.Bt + (size_t)cur.pn * tstep;
    S.a_ready(cur);
    if constexpr (SP2) {
        PG8_STAGE(PG8_SB(0, 0), cB, voffB); PG8_STAGE(PG8_SB(0, 1), cB + hstep, voffB); PG8_STAGE(PG8_SA(0, 0), cA, voffA); PG8_STAGE(PG8_SA(0, 1), cA + hstep, voffA);
        if (wr == 1) PG8_BAR;
        PG8_WAIT_V(2); PG8_BAR;
        PG8_STAGE(PG8_SB(1, 0), cB + kstep, voffB); PG8_STAGE(PG8_SA(1, 0), cA + kstep, voffA); PG8_STAGE(PG8_SB(1, 1), cB + hstep + kstep, voffB);
        PG8_WAIT_V(6); PG8_BAR;
    } else {
        PG8_STAGE(PG8_SB(0, 0), cB, voffB); PG8_STAGE(PG8_SA(0, 0), cA, voffA); PG8_STAGE(PG8_SB(0, 1), cB + hstep, voffB); PG8_STAGE(PG8_SA(0, 1), cA + hstep, voffA);
        if (wr == 1) PG8_BAR;
        PG8_WAIT_V(4); PG8_BAR;
        PG8_STAGE(PG8_SB(1, 0), cB + kstep, voffB); PG8_STAGE(PG8_SA(1, 0), cA + kstep, voffA); PG8_STAGE(PG8_SB(1, 1), cB + hstep + kstep, voffB);
        PG8_WAIT_V(6); PG8_BAR;
    }
    for (;;) {
        const bool has_next = S.next(ui + 1, nxt);
        const char* nA = has_next ? (const char*)g.A + (size_t)nxt.pm * tstep : cA; const char* nB = has_next ? (const char*)g.Bt + (size_t)nxt.pn * tstep : cB;
        for (int t = 0; t < nt; t += 2) {
            if constexpr (Epi::MID) { if (t == (nt >> 1)) E.mid(acc, cur, wr, wc, fr, fq); }
            const bool last = (t == nt - 2);
            const char* a1 = cA + (size_t)(t + 1) * kstep;
            const char* a2 = last ? nA : cA + (size_t)(t + 2) * kstep; const char* b2 = last ? nB : cB + (size_t)(t + 2) * kstep;
            const char* a3 = a2 + kstep; const char* b3 = b2 + kstep;
            if (last && has_next) S.a_ready(nxt);
            if constexpr (SP2) {
            PG8_LDB(B0, 0, 0); PG8_LDB(B1, 0, 1); PG8_SCHED; PG8_LDA(At, 0, 0); PG8_STAGE(PG8_SA(1, 1), a1 + hstep, voffA);
            PG8_WAIT_V(8); PG8_WAIT_L(0); PG8_BAR; PG8_MMA(0, 0, At, B0); PG8_MMA(0, 1, At, B1); PG8_BAR; PG8_SCHED;
            PG8_LDA(At, 0, 1); PG8_STAGE(PG8_SB(0, 0), b2, voffB); PG8_STAGE(PG8_SB(0, 1), b2 + hstep, voffB); PG8_STAGE(PG8_SA(0, 0), a2, voffA);
            PG8_WAIT_V(8); PG8_WAIT_L(0); PG8_BAR; PG8_MMA(1, 0, At, B0); PG8_MMA(1, 1, At, B1); PG8_BAR; PG8_SCHED;
            PG8_LDB(B0, 1, 0); PG8_LDB(B1, 1, 1); PG8_SCHED; PG8_LDA(At, 1, 0); PG8_STAGE(PG8_SA(0, 1), a2 + hstep, voffA);
            PG8_WAIT_V(8); PG8_WAIT_L(0); PG8_BAR; PG8_MMA(0, 0, At, B0); PG8_MMA(0, 1, At, B1); PG8_BAR; PG8_SCHED;
            PG8_LDA(At, 1, 1); PG8_STAGE(PG8_SB(1, 0), b3, voffB); PG8_STAGE(PG8_SB(1, 1), b3 + hstep, voffB); PG8_STAGE(PG8_SA(1, 0), a3, voffA);
            PG8_WAIT_V(8); PG8_WAIT_L(0); PG8_BAR; PG8_MMA(1, 0, At, B0); PG8_MMA(1, 1, At, B1); PG8_BAR; PG8_SCHED;
            } else {
            PG8_LDB(B0, 0, 0); PG8_SCHED; PG8_LDA(At, 0, 0); PG8_STAGE(PG8_SA(1, 1), a1 + hstep, voffA);
            PG8_WAIT_L(8); PG8_BAR; PG8_WAIT_L(0); PG8_MMA(0, 0, At, B0); PG8_BAR; PG8_SCHED;
            PG8_LDB(B1, 0, 1); PG8_STAGE(PG8_SB(0, 0), b2, voffB);
            PG8_BAR; PG8_WAIT_L(0); PG8_MMA(0, 1, At, B1); PG8_BAR;
            PG8_LDA(At, 0, 1); PG8_STAGE(PG8_SA(0, 0), a2, voffA);
            PG8_BAR; PG8_WAIT_L(0); PG8_MMA(1, 0, At, B0); PG8_BAR; PG8_SCHED;
            PG8_STAGE(PG8_SB(0, 1), b2 + hstep, voffB);
            PG8_WAIT_V(6); PG8_BAR; PG8_MMA(1, 1, At, B1); PG8_BAR;
            PG8_LDB(B0, 1, 0); PG8_SCHED; PG8_LDA(At, 1, 0); PG8_STAGE(PG8_SA(0, 1), a2 + hstep, voffA);
            PG8_WAIT_L(8); PG8_BAR; PG8_WAIT_L(0); PG8_MMA(0, 0, At, B0); PG8_BAR; PG8_SCHED;
            PG8_LDB(B1, 1, 1); PG8_STAGE(PG8_SB(1, 0), b3, voffB);
            PG8_BAR; PG8_WAIT_L(0); PG8_MMA(0, 1, At, B1); PG8_BAR;
            PG8_LDA(At, 1, 1); PG8_STAGE(PG8_SA(1, 0), a3, voffA);
            PG8_BAR; PG8_WAIT_L(0); PG8_MMA(1, 0, At, B0); PG8_BAR; PG8_SCHED;
            PG8_STAGE(PG8_SB(1, 1), b3 + hstep, voffB);
            PG8_WAIT_V(6); PG8_BAR; PG8_MMA(1, 1, At, B1); PG8_BAR;
            }
        }
        if constexpr (ALIGN_EPI) { if (wr == 0) PG8_BAR; }
        if constexpr (!Epi::AFTER_DRAIN) { E(acc, cur, wr, wc, fr, fq); S.done(cur); }
        if (!has_next) break;
#pragma unroll
        for (int a = 0; a < 2; ++a)
#pragma unroll
            for (int b = 0; b < 2; ++b)
#pragma unroll
                for (int m = 0; m < 4; ++m)
#pragma unroll
                    for (int n = 0; n < 2; ++n) acc[a][b][m][n] = (f32x4){0.f, 0.f, 0.f, 0.f};
        cur = nxt; cA = nA; cB = nB; ++ui;
        if constexpr (ALIGN_EPI) { if (wr == 1) PG8_BAR; }
    }
    PG8_WAIT_V(0);
    if constexpr (!ALIGN_EPI) { if (wr == 0) PG8_BAR; }
    PG8_BAR;
    if constexpr (Epi::AFTER_DRAIN) { E.fused(acc, cur, wr, wc, fr, fq, lds, wid, lane); S.done(cur); }
#undef PG8_SA
#undef PG8_SB
#undef PG8_STAGE
#undef PG8_LDA
#undef PG8_LDB
#undef PG8_MMA
#undef PG8_WAIT_V
#undef PG8_WAIT_L
#undef PG8_BAR
#undef PG8_SCHED
}
}
#define LAS __attribute__((address_space(3)))
typedef unsigned short bf16;
typedef unsigned v4u __attribute__((ext_vector_type(4)));
typedef unsigned v2u __attribute__((ext_vector_type(2)));
typedef float f32x4 __attribute__((ext_vector_type(4)));
typedef float f32x16 __attribute__((ext_vector_type(16)));
typedef short bf16x8 __attribute__((ext_vector_type(8)));
constexpr int T = 16384, D = 1024, FF = 2816, SEQ = 2048, NHEAD = 8, PW = 512, INW = 4096;
constexpr float RMS_EPS = 1e-6f;
constexpr int NWAVES = 8, LDS_BYTES = 147456;
constexpr int NPHASE = 10;
constexpr int LDSCTL_OFF = 131072, MISC_OFF = LDSCTL_OFF + 320;
constexpr int RSL_OFF = LDSCTL_OFF + 1024;
constexpr int CW_BAR = 4096;
constexpr int CW_CNT = 12288;
constexpr size_t CTL_ZERO_BYTES = 65536;
#ifndef PROBE_REPEAT
#define PROBE_REPEAT -1
#endif
#ifndef PROBE_DOUBLE_SEAM
#define PROBE_DOUBLE_SEAM 0
#endif
#ifndef PROBE_ATTN2
#define PROBE_ATTN2 0
#endif
#ifndef PROBE_POOL2
#define PROBE_POOL2 0
#endif
#ifndef PROBE_NOEXIT
#define PROBE_NOEXIT 0
#endif
#ifndef PROBE_SPLIT
#define PROBE_SPLIT -1
#endif
#ifndef PHASE_MASK
#define PHASE_MASK 1023
#endif
constexpr size_t MiB = 1u << 20;
constexpr size_t WS_W1GU = 2 * MiB, WS_W1D = 13 * MiB, WS_WIN = 19 * MiB, WS_WCOMB = 27 * MiB, WS_WA = 28 * MiB, WS_WOUT = 29 * MiB, WS_W2GU = 31 * MiB, WS_W2D = 42 * MiB;
constexpr size_t WS_SSQ = 48 * MiB;
constexpr size_t WS_HB = 52 * MiB;
constexpr size_t WS_BIG = 84 * MiB;
constexpr size_t WS_P4 = WS_BIG, WS_G = WS_BIG + 64 * MiB, WS_MB = WS_BIG + 32 * MiB;
constexpr size_t WS_PO = WS_BIG + 128 * MiB;
constexpr size_t WS_END = WS_PO + 32 * MiB;
static_assert(WS_W2D + (size_t)D * FF * 2 <= WS_SSQ && WS_SSQ + 3 * MiB <= WS_HB && WS_HB + 32 * MiB <= WS_BIG && (size_t)T * FF * 2 <= 128 * MiB && WS_END <= 256 * MiB, "d_ws map");

__device__ __forceinline__ unsigned f2bf(float f) { unsigned u = __builtin_bit_cast(unsigned, f); return (u + 0x7fffu + ((u >> 16) & 1u)) >> 16; }
__device__ __forceinline__ unsigned pk2(float lo, float hi) { return pg8::cvt_pk_bf16(lo, hi); }
__device__ __forceinline__ float bflo(unsigned w) { return __builtin_bit_cast(float, w << 16); }
__device__ __forceinline__ float bfhi(unsigned w) { return __builtin_bit_cast(float, w & 0xffff0000u); }
__device__ __forceinline__ float wave_sum(float v) {
#pragma unroll
    for (int o = 1; o < 64; o <<= 1) v += __shfl_xor(v, o);
    return v;
}
#define LDS_WAIT() asm volatile("s_waitcnt lgkmcnt(0)" ::: "memory")

__device__ __forceinline__ void tr_item(const float* W, int K, int N, bf16* WT, int ldw, int koff, const float* ks, int il, int ib, int item, LAS float* scr, int lane) {
    const int nblk = N / 64, kb = item / nblk, nb = item % nblk, k0 = 64 * kb, n0 = 64 * nb;
    int drow = n0;
    if (il > 0 && n0 >= ib) { const int second = (n0 - ib) >= il ? 1 : 0, j = n0 - ib - second * il; drow = ib + 256 * (j / 128) + 128 * second + (j % 128); }
    float va[32], vb[32];
#pragma unroll
    for (int i = 0; i < 32; ++i) { const int kk = 2 * i + (lane >> 5); const float* p = W + (size_t)(k0 + kk) * N + n0 + (lane & 31); va[i] = p[0]; vb[i] = p[32]; }
    if (ks) {
#pragma unroll
        for (int i = 0; i < 32; ++i) { const float sc = ks[k0 + 2 * i + (lane >> 5)]; va[i] *= sc; vb[i] *= sc; }
    }
    const int c = lane & 7;
#pragma unroll
    for (int h = 0; h < 2; ++h) {
#pragma unroll
        for (int i = 0; i < 32; ++i) scr[(2 * i + (lane >> 5)) * 33 + (lane & 31)] = h ? vb[i] : va[i];
        LDS_WAIT(); asm volatile("" ::: "memory");
#pragma unroll
        for (int j = 0; j < 4; ++j) { const int n = (lane >> 3) + 8 * j; const LAS float* s = scr + (8 * c) * 33 + n;
            v4u o; o.x = pk2(s[0 * 33], s[1 * 33]); o.y = pk2(s[2 * 33], s[3 * 33]); o.z = pk2(s[4 * 33], s[5 * 33]); o.w = pk2(s[6 * 33], s[7 * 33]);
            *(v4u*)(WT + (size_t)(drow + 32 * h + n) * ldw + koff + k0 + 8 * c) = o; }
        LDS_WAIT(); asm volatile("" ::: "memory");
    }
}
__device__ __forceinline__ void comb_item(const float* wg, const float* psc, const float* wbp, bf16* WC, int item, int lane) {
    const int nb = item >> 6, kc = item & 63, n = nb * 64 + lane, k0 = kc * 8, g = k0 >> 7, c0 = k0 & 127;
    float acc[8];
#pragma unroll
    for (int i = 0; i < 8; ++i) acc[i] = 0.f;
    const float* wrow = wg + (size_t)(g * 128 + c0) * 128;
#pragma unroll 32
    for (int d = 0; d < 128; ++d) {
        const float wv = wbp[(size_t)(g * 128 + d) * 1024 + n] * psc[g * 128 + d];
#pragma unroll
        for (int i = 0; i < 8; ++i) acc[i] += wrow[i * 128 + d] * wv;
    }
    v4u o; o.x = pk2(acc[0], acc[1]); o.y = pk2(acc[2], acc[3]); o.z = pk2(acc[4], acc[5]); o.w = pk2(acc[6], acc[7]);
    *(v4u*)(WC + (size_t)n * 1024 + k0) = o;
}
__device__ __forceinline__ void comb_block(const float* wg, const float* psc, const float* wbp, bf16* WC, int blk, LAS unsigned char* lds, int wave, int lane, int tid) {
    const int kc = blk >> 2, nq = blk & 3, k0 = kc * 8, g = k0 >> 7, c0 = k0 & 127, d0 = 16 * wave;
    const float* wrow = wg + (size_t)(g * 128 + c0) * 128 + d0;
    const float* wb = wbp + (size_t)(g * 128 + d0) * 1024 + nq * 256 + 4 * lane;
    f32x4 wv[16];
#pragma unroll
    for (int dd = 0; dd < 16; ++dd) wv[dd] = *(const f32x4*)(wb + (size_t)dd * 1024);
    f32x4 acc[8];
#pragma unroll
    for (int i = 0; i < 8; ++i) acc[i] = (f32x4){0.f, 0.f, 0.f, 0.f};
#pragma unroll
    for (int dd = 0; dd < 16; ++dd) { const f32x4 v = wv[dd] * psc[g * 128 + d0 + dd];
#pragma unroll
        for (int i = 0; i < 8; ++i) acc[i] += v * wrow[i * 128 + dd]; }
    LAS f32x4* red = (LAS f32x4*)lds;
#pragma unroll
    for (int i = 0; i < 8; ++i) red[(wave * 8 + i) * 64 + lane] = acc[i];
    __syncthreads();
    const int nl = tid & 255, kh = tid >> 8; const LAS float* rf = (const LAS float*)lds;
    float o[4];
#pragma unroll
    for (int j = 0; j < 4; ++j) { float s = 0.f;
#pragma unroll
        for (int w = 0; w < 8; ++w) s += rf[(((w * 8 + 4 * kh + j) * 64 + (nl >> 2)) << 2) + (nl & 3)];
        o[j] = s; }
    v2u pk; pk.x = pk2(o[0], o[1]); pk.y = pk2(o[2], o[3]);
    *(v2u*)(WC + (size_t)(nq * 256 + nl) * 1024 + k0 + 4 * kh) = pk;
    __syncthreads();
}
__device__ __forceinline__ void rms_rows4_bf16(const float* x4, const float* gain, bf16* o4, int lane) {
    const f32x4* gr = (const f32x4*)gain + lane;
    f32x4 v[4][4]; float s[4];
#pragma unroll
    for (int r = 0; r < 4; ++r)
#pragma unroll
        for (int j = 0; j < 4; ++j) v[r][j] = ((const f32x4*)(x4 + (size_t)r * D) + lane)[64 * j];
#pragma unroll
    for (int r = 0; r < 4; ++r) { s[r] = 0.f;
#pragma unroll
        for (int j = 0; j < 4; ++j) s[r] += (v[r][j].x * v[r][j].x + v[r][j].y * v[r][j].y) + (v[r][j].z * v[r][j].z + v[r][j].w * v[r][j].w); }
#pragma unroll
    for (int r = 0; r < 4; ++r) {
        const float rs = 1.0f / sqrtf(wave_sum(s[r]) * (1.0f / D) + RMS_EPS);
        unsigned long long* o8 = (unsigned long long*)(o4 + (size_t)r * D) + lane;
#pragma unroll
        for (int j = 0; j < 4; ++j) { const f32x4 gv = gr[64 * j]; const f32x4 o = v[r][j] * rs * gv;
            o8[64 * j] = (unsigned long long)pk2(o.x, o.y) | ((unsigned long long)pk2(o.z, o.w) << 32); }
    }
}
__device__ __forceinline__ void xb_rows4(const float* x4, bf16* o4, float* ssq4, int lane) {
    f32x4 v[4][4]; float s[4];
#pragma unroll
    for (int r = 0; r < 4; ++r)
#pragma unroll
        for (int j = 0; j < 4; ++j) v[r][j] = ((const f32x4*)(x4 + (size_t)r * D) + lane)[64 * j];
#pragma unroll
    for (int r = 0; r < 4; ++r) { s[r] = 0.f;
#pragma unroll
        for (int j = 0; j < 4; ++j) s[r] += (v[r][j].x * v[r][j].x + v[r][j].y * v[r][j].y) + (v[r][j].z * v[r][j].z + v[r][j].w * v[r][j].w); }
#pragma unroll
    for (int r = 0; r < 4; ++r) {
        const float t = wave_sum(s[r]);
        unsigned long long* o8 = (unsigned long long*)(o4 + (size_t)r * D) + lane;
#pragma unroll
        for (int j = 0; j < 4; ++j) o8[64 * j] = (unsigned long long)pk2(v[r][j].x, v[r][j].y) | ((unsigned long long)pk2(v[r][j].z, v[r][j].w) << 32);
        if (lane < 16) ssq4[r * 16 + lane] = lane ? 0.f : t;
    }
}
__device__ __forceinline__ void rms_row_f32(float* xrow, const float* gain, int lane) {
    f32x4* xr = (f32x4*)xrow + lane; const f32x4* gr = (const f32x4*)gain + lane;
    f32x4 v[4]; float s = 0.f;
#pragma unroll
    for (int j = 0; j < 4; ++j) { v[j] = xr[64 * j]; s += (v[j].x * v[j].x + v[j].y * v[j].y) + (v[j].z * v[j].z + v[j].w * v[j].w); }
    const float rs = 1.0f / sqrtf(wave_sum(s) * (1.0f / D) + RMS_EPS);
#pragma unroll
    for (int j = 0; j < 4; ++j) { const f32x4 gv = gr[64 * j]; xr[64 * j] = v[j] * rs * gv; }
}

namespace sb {
__device__ __forceinline__ void attn_wave(int bh, int rb, const bf16* Qp, const bf16* Kp, const bf16* Vt, bf16* Op  , int lane) {
    const int r32 = lane & 31, hi = lane >> 5, b = bh >> 3, h = bh & 7;
    const size_t rowbase = (size_t)b * SEQ;
    const int tq = rb * 32 + r32;
    const int kap = 16 * ((r32 >> 2) & 1) + (r32 & 3) + 4 * (r32 >> 3);
    bf16x8 qr[4];
    { const bf16* qrow = Qp + (rowbase + tq) * 512 + h * 64 + hi * 8;
#pragma unroll
      for (int s = 0; s < 4; ++s) qr[s] = *(const bf16x8*)(qrow + s * 16); }
    const bf16* kbase = Kp + (rowbase + kap) * 512 + h * 64 + hi * 8;
    const bf16* vbase = Vt + ((size_t)bh * 64 + r32) * 2048 + 16 * hi;
    f32x16 o0, o1;
#pragma unroll
    for (int r = 0; r < 16; ++r) { o0[r] = 0.f; o1[r] = 0.f; }
    float R = 1.0f;
#define SB_LOAD(KF, VF, JB) do { const int jl_ = (JB) > 0 ? (JB) : 0; _Pragma("unroll") for (int s = 0; s < 4; ++s) { \
        KF[s] = *(const bf16x8*)(kbase + (size_t)(32 * jl_) * 512 + 16 * s); VF[s] = *(const bf16x8*)(vbase + (size_t)(s >> 1) * 32 * 2048 + 32 * jl_ + 8 * (s & 1)); } } while (0)
#define SB_BLOCK(KF, VF, JB, MASKED) do { \
        f32x16 c; _Pragma("unroll") for (int r = 0; r < 16; ++r) c[r] = 0.f; \
        _Pragma("unroll") for (int s = 0; s < 4; ++s) c = __builtin_amdgcn_mfma_f32_32x32x16_bf16(KF[s], qr[s], c, 0, 0, 0); \
        const int lim = tq - (32 * (JB) + 16 * hi);                                \
        float mm[16]; \
        _Pragma("unroll") for (int r = 0; r < 16; ++r) { const float e = __builtin_amdgcn_exp2f(c[r]); float m = __builtin_amdgcn_rcpf(1.0f + e); if (MASKED && r >= lim) m = 1.0f; mm[r] = m; } \
        const float Tp = (((mm[0] * mm[1]) * (mm[2] * mm[3])) * ((mm[4] * mm[5]) * (mm[6] * mm[7]))) * (((mm[8] * mm[9]) * (mm[10] * mm[11])) * ((mm[12] * mm[13]) * (mm[14] * mm[15]))); \
        const float To = __shfl_xor(Tp, 32); \
        float Rl = hi ? R : R * To;                                                \
        float av[16]; \
        _Pragma("unroll") for (int r = 15; r >= 0; --r) { const float Rn = Rl * mm[r]; av[r] = Rl - Rn; Rl = Rn; } \
        R = R * Tp * To; \
        v4u p0, p1; \
        p0.x = pg8::cvt_pk_bf16(av[0], av[1]); p0.y = pg8::cvt_pk_bf16(av[2], av[3]); p0.z = pg8::cvt_pk_bf16(av[4], av[5]); p0.w = pg8::cvt_pk_bf16(av[6], av[7]); \
        p1.x = pg8::cvt_pk_bf16(av[8], av[9]); p1.y = pg8::cvt_pk_bf16(av[10], av[11]); p1.z = pg8::cvt_pk_bf16(av[12], av[13]); p1.w = pg8::cvt_pk_bf16(av[14], av[15]); \
        const bf16x8 pb0 = __builtin_bit_cast(bf16x8, p0), pb1 = __builtin_bit_cast(bf16x8, p1); \
        o0 = __builtin_amdgcn_mfma_f32_32x32x16_bf16(VF[0], pb0, o0, 0, 0, 0); o0 = __builtin_amdgcn_mfma_f32_32x32x16_bf16(VF[1], pb1, o0, 0, 0, 0); \
        o1 = __builtin_amdgcn_mfma_f32_32x32x16_bf16(VF[2], pb0, o1, 0, 0, 0); o1 = __builtin_amdgcn_mfma_f32_32x32x16_bf16(VF[3], pb1, o1, 0, 0, 0); } while (0)
#define SB_DONE(JB) ((JB) == 0 || (!PROBE_NOEXIT && __builtin_amdgcn_ballot_w64(R != 0.0f) == 0ull))
    bf16x8 ka[4], va[4], kb2[4], vb2[4], kc[4], vc[4];
    SB_LOAD(ka, va, rb); SB_LOAD(kb2, vb2, rb - 1);
    SB_LOAD(kc, vc, rb - 2); SB_BLOCK(ka, va, rb, true);
    if (!SB_DONE(rb)) for (int jb = rb - 1;; jb -= 3) {
        SB_LOAD(ka, va, jb - 2);   SB_BLOCK(kb2, vb2, jb, false);    if (SB_DONE(jb)) break;
        SB_LOAD(kb2, vb2, jb - 3); SB_BLOCK(kc, vc, jb - 1, false);  if (SB_DONE(jb - 1)) break;
        SB_LOAD(kc, vc, jb - 4);   SB_BLOCK(ka, va, jb - 2, false);  if (SB_DONE(jb - 2)) break;
    }
#undef SB_LOAD
#undef SB_BLOCK
#undef SB_DONE
    bf16* orow = Op + (rowbase + tq) * 1024 + h * 64 + 4 * hi;
#pragma unroll
    for (int g4 = 0; g4 < 4; ++g4) {
        v2u w0; w0.x = pg8::cvt_pk_bf16(o0[4 * g4], o0[4 * g4 + 1]); w0.y = pg8::cvt_pk_bf16(o0[4 * g4 + 2], o0[4 * g4 + 3]); *(v2u*)(orow + 8 * g4) = w0;
        v2u w1; w1.x = pg8::cvt_pk_bf16(o1[4 * g4], o1[4 * g4 + 1]); w1.y = pg8::cvt_pk_bf16(o1[4 * g4 + 2], o1[4 * g4 + 3]); *(v2u*)(orow + 32 + 8 * g4) = w1;
    }
}
__device__ __forceinline__ void attn_wave2(int bh, int u, const bf16* Qp, const bf16* Kp, const bf16* Vt, bf16* Op  , int lane) {
    const int r32 = lane & 31, hi = lane >> 5, b = bh >> 3, h = bh & 7;
    const size_t rowbase = (size_t)b * SEQ;
    const int tqA = 64 * u + r32, tqB = tqA + 32;
    const int kap = 16 * ((r32 >> 2) & 1) + (r32 & 3) + 4 * (r32 >> 3);
    bf16x8 qa[4], qb[4];
    { const bf16* qrow = Qp + (rowbase + tqA) * 512 + h * 64 + hi * 8;
#pragma unroll
      for (int s = 0; s < 4; ++s) { qa[s] = *(const bf16x8*)(qrow + s * 16); qb[s] = *(const bf16x8*)(qrow + (size_t)32 * 512 + s * 16); } }
    const bf16* kbase = Kp + (rowbase + kap) * 512 + h * 64 + hi * 8;
    const bf16* vbase = Vt + ((size_t)bh * 64 + r32) * 2048 + 16 * hi;
    f32x16 oa0, oa1, ob0, ob1;
#pragma unroll
    for (int r = 0; r < 16; ++r) { oa0[r] = 0.f; oa1[r] = 0.f; ob0[r] = 0.f; ob1[r] = 0.f; }
    float RA = 1.0f, RB = 1.0f;
#define SB_LOAD(KF, VF, JB) do { const int jl_ = (JB) > 0 ? (JB) : 0; _Pragma("unroll") for (int s = 0; s < 4; ++s) { \
        KF[s] = *(const bf16x8*)(kbase + (size_t)(32 * jl_) * 512 + 16 * s); VF[s] = *(const bf16x8*)(vbase + (size_t)(s >> 1) * 32 * 2048 + 32 * jl_ + 8 * (s & 1)); } } while (0)
#define SB_CHAIN(QR, O0, O1, RR, TQ, KF, VF, JB) do { \
        f32x16 c; _Pragma("unroll") for (int r = 0; r < 16; ++r) c[r] = 0.f; \
        _Pragma("unroll") for (int s = 0; s < 4; ++s) c = __builtin_amdgcn_mfma_f32_32x32x16_bf16(KF[s], QR[s], c, 0, 0, 0); \
        const int lim = (TQ) - (32 * (JB) + 16 * hi); \
        float mm[16]; \
        _Pragma("unroll") for (int r = 0; r < 16; ++r) { const float e = __builtin_amdgcn_exp2f(c[r]); float m = __builtin_amdgcn_rcpf(1.0f + e); if (r >= lim) m = 1.0f; mm[r] = m; } \
        const float Tp = (((mm[0] * mm[1]) * (mm[2] * mm[3])) * ((mm[4] * mm[5]) * (mm[6] * mm[7]))) * (((mm[8] * mm[9]) * (mm[10] * mm[11])) * ((mm[12] * mm[13]) * (mm[14] * mm[15]))); \
        const float To = __shfl_xor(Tp, 32); \
        float Rl = hi ? RR : RR * To; \
        float av[16]; \
        _Pragma("unroll") for (int r = 15; r >= 0; --r) { const float Rn = Rl * mm[r]; av[r] = Rl - Rn; Rl = Rn; } \
        RR = RR * Tp * To; \
        v4u p0, p1; \
        p0.x = pg8::cvt_pk_bf16(av[0], av[1]); p0.y = pg8::cvt_pk_bf16(av[2], av[3]); p0.z = pg8::cvt_pk_bf16(av[4], av[5]); p0.w = pg8::cvt_pk_bf16(av[6], av[7]); \
        p1.x = pg8::cvt_pk_bf16(av[8], av[9]); p1.y = pg8::cvt_pk_bf16(av[10], av[11]); p1.z = pg8::cvt_pk_bf16(av[12], av[13]); p1.w = pg8::cvt_pk_bf16(av[14], av[15]); \
        const bf16x8 pb0 = __builtin_bit_cast(bf16x8, p0), pb1 = __builtin_bit_cast(bf16x8, p1); \
        O0 = __builtin_amdgcn_mfma_f32_32x32x16_bf16(VF[0], pb0, O0, 0, 0, 0); O0 = __builtin_amdgcn_mfma_f32_32x32x16_bf16(VF[1], pb1, O0, 0, 0, 0); \
        O1 = __builtin_amdgcn_mfma_f32_32x32x16_bf16(VF[2], pb0, O1, 0, 0, 0); O1 = __builtin_amdgcn_mfma_f32_32x32x16_bf16(VF[3], pb1, O1, 0, 0, 0); } while (0)
#define SB_STEP(KF, VF, JB) do { SB_CHAIN(qb, ob0, ob1, RB, tqB, KF, VF, JB); SB_CHAIN(qa, oa0, oa1, RA, tqA, KF, VF, JB); } while (0)
#define SB_DONE(JB) ((JB) == 0 || __builtin_amdgcn_ballot_w64(RA != 0.0f || RB != 0.0f) == 0ull)
    const int jt = 2 * u + 1;
    bf16x8 ka[4], va[4], kb2[4], vb2[4], kc[4], vc[4];
    SB_LOAD(ka, va, jt); SB_LOAD(kb2, vb2, jt - 1); SB_LOAD(kc, vc, jt - 2);
    SB_CHAIN(qb, ob0, ob1, RB, tqB, ka, va, jt);
    for (int jb = jt - 1;; jb -= 3) {
        SB_LOAD(ka, va, jb - 2);   SB_STEP(kb2, vb2, jb);    if (SB_DONE(jb)) break;
        SB_LOAD(kb2, vb2, jb - 3); SB_STEP(kc, vc, jb - 1);  if (SB_DONE(jb - 1)) break;
        SB_LOAD(kc, vc, jb - 4);   SB_STEP(ka, va, jb - 2);  if (SB_DONE(jb - 2)) break;
    }
#undef SB_LOAD
#undef SB_CHAIN
#undef SB_STEP
#undef SB_DONE
    bf16* orow = Op + (rowbase + tqA) * 1024 + h * 64 + 4 * hi;
#pragma unroll
    for (int g4 = 0; g4 < 4; ++g4) {
        v2u w; w.x = pg8::cvt_pk_bf16(oa0[4 * g4], oa0[4 * g4 + 1]); w.y = pg8::cvt_pk_bf16(oa0[4 * g4 + 2], oa0[4 * g4 + 3]); *(v2u*)(orow + 8 * g4) = w;
        w.x = pg8::cvt_pk_bf16(oa1[4 * g4], oa1[4 * g4 + 1]); w.y = pg8::cvt_pk_bf16(oa1[4 * g4 + 2], oa1[4 * g4 + 3]); *(v2u*)(orow + 32 + 8 * g4) = w;
        w.x = pg8::cvt_pk_bf16(ob0[4 * g4], ob0[4 * g4 + 1]); w.y = pg8::cvt_pk_bf16(ob0[4 * g4 + 2], ob0[4 * g4 + 3]); *(v2u*)(orow + (size_t)32 * 1024 + 8 * g4) = w;
        w.x = pg8::cvt_pk_bf16(ob1[4 * g4], ob1[4 * g4 + 1]); w.y = pg8::cvt_pk_bf16(ob1[4 * g4 + 2], ob1[4 * g4 + 3]); *(v2u*)(orow + (size_t)32 * 1024 + 32 + 8 * g4) = w;
    }
}
}

template <int W> __device__ __forceinline__ void pool_run(const bf16* XP, bf16* PO, int t0, int ch8) {
    constexpr int RUN = 8;
    const int pos0 = t0 & (SEQ - 1); const bf16* p = XP + (size_t)t0 * 512 + ch8 * 8;
    v4u v[W - 1 + RUN];
#pragma unroll
    for (int i = 0; i < W - 1 + RUN; ++i) { const int rel = i - (W - 1), rc = (pos0 + rel >= 0) ? rel : -pos0; v[i] = *(const v4u*)(p + (long)rc * 512); }
#pragma unroll
    for (int i = 0; i < W - 1; ++i) { if (pos0 + (i - (W - 1)) < 0) v[i] = (v4u){0u, 0u, 0u, 0u}; }
    float s[8];
#pragma unroll
    for (int k = 0; k < 8; ++k) s[k] = 0.f;
#pragma unroll
    for (int i = 0; i < W - 1; ++i) { s[0] += bflo(v[i].x); s[1] += bfhi(v[i].x); s[2] += bflo(v[i].y); s[3] += bfhi(v[i].y); s[4] += bflo(v[i].z); s[5] += bfhi(v[i].z); s[6] += bflo(v[i].w); s[7] += bfhi(v[i].w); }
#pragma unroll
    for (int j = 0; j < RUN; ++j) {
        const v4u x0 = v[W - 1 + j], xo = v[j];
        s[0] += bflo(x0.x); s[1] += bfhi(x0.x); s[2] += bflo(x0.y); s[3] += bfhi(x0.y); s[4] += bflo(x0.z); s[5] += bfhi(x0.z); s[6] += bflo(x0.w); s[7] += bfhi(x0.w);
        const int cnt = (pos0 + j + 1 < W) ? pos0 + j + 1 : W; const float inv = 1.0f / (float)cnt;
        v4u o; o.x = pk2(s[0] * inv - bflo(x0.x), s[1] * inv - bfhi(x0.x)); o.y = pk2(s[2] * inv - bflo(x0.y), s[3] * inv - bfhi(x0.y));
        o.z = pk2(s[4] * inv - bflo(x0.z), s[5] * inv - bfhi(x0.z)); o.w = pk2(s[6] * inv - bflo(x0.w), s[7] * inv - bfhi(x0.w));
        *(v4u*)(PO + (size_t)(t0 + j) * 1024 + ch8 * 8) = o;
        s[0] -= bflo(xo.x); s[1] -= bfhi(xo.x); s[2] -= bflo(xo.y); s[3] -= bfhi(xo.y); s[4] -= bflo(xo.z); s[5] -= bfhi(xo.z); s[6] -= bflo(xo.w); s[7] -= bfhi(xo.w);
    }
}
__device__ __forceinline__ void pool_phase(const bf16* XP, bf16* PO, int gwp, int NGW, int lane) {
    for (int wi = gwp; wi < 4 * (T / 32); wi += NGW) {
        const int wq = wi % (T / 32), g = 3 - (wi / (T / 32) + wq) % 4, t0 = 32 * wq + 8 * (lane >> 4), ch8 = 16 * g + (lane & 15);
        if (g == 3) pool_run<16>(XP, PO, t0, ch8); else if (g == 2) pool_run<8>(XP, PO, t0, ch8); else if (g == 1) pool_run<4>(XP, PO, t0, ch8); else pool_run<2>(XP, PO, t0, ch8);
    }
}

#define XB_TMO      128
#define XB_XCNT(j)  (256  + 64 * (j))
#define XB_XSUB(j)  (1280 + 64 * (j))
#define XB_XGEN(j)  (2304 + 64 * (j))
#define XB_TOP      3328
#define XB_TOPGEN   3392
#define XCD_BAR_WORDS 3456
#define XB_SPIN_CAP (1u << 18)

__device__ __forceinline__ unsigned xb_ld(unsigned* p)              { return __hip_atomic_load(p, __ATOMIC_RELAXED, __HIP_MEMORY_SCOPE_AGENT); }
__device__ __forceinline__ unsigned xb_add(unsigned* p, unsigned v) { return __hip_atomic_fetch_add(p, v, __ATOMIC_RELAXED, __HIP_MEMORY_SCOPE_AGENT); }
__device__ __forceinline__ unsigned xb_xcc_id() { return (unsigned)__builtin_amdgcn_s_getreg((3 << 11) | 20) & 0xFu; }
#define XB_SPIN(cond, bar) do { unsigned _sp = 0; while (cond) { __builtin_amdgcn_s_sleep(1); \
    if ((++_sp & 255u) == 0u) { if (xb_ld(&(bar)[XB_TMO])) break; if (_sp > XB_SPIN_CAP) { atomicAdd(&(bar)[XB_TMO], 1u); break; } } } } while (0)

struct XcdBarrier {
    unsigned* bar; unsigned x;
    volatile LAS unsigned* st;
};

__device__ __forceinline__ XcdBarrier xcd_barrier_post(unsigned* bar, volatile LAS unsigned* st) {
    XcdBarrier b; b.bar = bar; b.x = xb_xcc_id(); b.st = st;
    if (threadIdx.x == 0) (void)xb_add(&bar[XB_XCNT(b.x)], 1u);
    return b;
}
__device__ __forceinline__ void xcd_barrier_complete(unsigned* bar, unsigned x, unsigned& nloc, unsigned& nx) {
    const unsigned G = gridDim.x * gridDim.y * gridDim.z;
    unsigned sum, cnt, mine, sp = 0u;
    for (;;) {
        sum = 0u; cnt = 0u; mine = 0u;
#pragma unroll
        for (unsigned j = 0; j < 16; ++j) { const unsigned c = xb_ld(&bar[XB_XCNT(j)]); sum += c; cnt += (c > 0u) ? 1u : 0u; mine = (j == x) ? c : mine; }
        if (sum == G) break;
        __builtin_amdgcn_s_sleep(1);
        if ((++sp & 255u) == 0u) { if (xb_ld(&bar[XB_TMO])) break; if (sp > XB_SPIN_CAP) { atomicAdd(&bar[XB_TMO], 1u); break; } }
    }
    nloc = mine > 0u ? mine : 1u; nx = cnt > 0u ? cnt : 1u;
}

__device__ __forceinline__ void xcd_barrier(const XcdBarrier& b) {
    asm volatile("s_waitcnt vmcnt(0)" ::: "memory");
    __syncthreads();
    if (threadIdx.x == 0) {
        unsigned* bar = b.bar;
        __builtin_amdgcn_s_waitcnt(0);
        unsigned nloc = b.st[0], nx = b.st[1];
        if (nloc == 0u) { xcd_barrier_complete(bar, b.x, nloc, nx); b.st[0] = nloc; b.st[1] = nx; }
        const unsigned old = xb_add(&bar[XB_XSUB(b.x)], 1u);
        const unsigned gen = old / nloc;
        if (old + 1u == (gen + 1u) * nloc) {
            __builtin_amdgcn_fence(__ATOMIC_RELEASE, "agent");
            asm volatile("s_waitcnt vmcnt(0)" ::: "memory");
            const unsigned og = xb_add(&bar[XB_TOP], 1u);
            const unsigned tg = og / nx;
            if (og + 1u == (tg + 1u) * nx) xb_add(&bar[XB_TOPGEN], 1u);
            else XB_SPIN(xb_ld(&bar[XB_TOPGEN]) == tg, bar);
            __builtin_amdgcn_fence(__ATOMIC_ACQUIRE, "agent");
            xb_add(&bar[XB_XGEN(b.x)], 1u);
            asm volatile("s_waitcnt vmcnt(0)" ::: "memory");
        } else {
            XB_SPIN(xb_ld(&bar[XB_XGEN(b.x)]) == gen, bar);
            __builtin_amdgcn_fence(__ATOMIC_ACQUIRE, "agent");
            asm volatile("s_waitcnt vmcnt(0)" ::: "memory");
        }
    }
    __syncthreads();
}

struct Args { const float* in[15]; float* out; unsigned char* ws; int ph_lo, ph_hi, li, pad; };
__global__ void __launch_bounds__(NWAVES * 64, 2) mega(Args a) {
    extern __shared__ __attribute__((aligned(16))) unsigned char lds_raw[];
    LAS unsigned char* lds = (LAS unsigned char*)lds_raw;
    const int tid = threadIdx.x, lane = tid & 63, wave = __builtin_amdgcn_readfirstlane(tid >> 6);
    const int G = gridDim.x, bx = blockIdx.x, vcu = (G % 8 == 0) ? (bx % 8) * (G / 8) + bx / 8 : bx;
    unsigned char* const ws = a.ws;
#define W1GU ((bf16*)(ws + WS_W1GU))
#define W1D ((bf16*)(ws + WS_W1D))
#define WIN ((bf16*)(ws + WS_WIN))
#define WBR ((bf16*)(ws + WS_WCOMB))
#define WOUT ((bf16*)(ws + WS_WOUT))
#define W2GU ((bf16*)(ws + WS_W2GU))
#define W2D ((bf16*)(ws + WS_W2D))
#define SSQ1 ((float*)(ws + WS_SSQ))
#define SSQ2 ((float*)(ws + WS_SSQ) + (size_t)T * 16)
#define SSQ0 ((float*)(ws + WS_SSQ) + (size_t)2 * T * 16)
#define HB ((bf16*)(ws + WS_HB))
#define ACT ((bf16*)(ws + WS_BIG))
#define P4 ((bf16*)(ws + WS_P4))
#define GR ((bf16*)(ws + WS_G))
#define GS ((bf16*)(ws + WS_G) + (size_t)T * 1024)
#define MB ((bf16*)(ws + WS_MB))
#define XP P4
#define QO (P4 + (size_t)T * 512)
#define KB (P4 + (size_t)2 * T * 512)
#define VB (P4 + (size_t)3 * T * 512)
#define H (a.out)
#define PO ((bf16*)(ws + WS_PO))
#define HB2 PO
#define OB (PO + 512)
    cg::grid_group grid = cg::this_grid();
    for (int u = tid; u < (LDS_BYTES - LDSCTL_OFF) / 4; u += NWAVES * 64) ((LAS unsigned*)(lds + LDSCTL_OFF))[u] = 0u;
    __syncthreads();
    const XcdBarrier bar = xcd_barrier_post((unsigned*)ws + CW_BAR + a.li * XCD_BAR_WORDS, (volatile LAS unsigned*)(lds + MISC_OFF) + 8);
    const int gwp = wave * G + vcu, NGW = G * NWAVES;

    const int lo = a.ph_lo, hi = a.ph_hi;
#define IN(k) ((PHASE_MASK >> (k)) & 1) && (lo <= (k) && (k) < hi)
#define SEAM(k) do { if ((k) + 1 < hi) { if (hi > NPHASE) grid.sync(); else { xcd_barrier(bar); if (PROBE_DOUBLE_SEAM) xcd_barrier(bar); } } } while (0)
    if (IN(0)) {
        LAS float* scr = (LAS float*)(lds + wave * 16384);
        for (int blk = bx; blk < 256; blk += G) comb_block(a.in[6], a.in[7], a.in[8], WBR, blk, lds, wave, lane, tid);
        constexpr int I_GU = (D / 64) * (2 * FF / 64), NITEMS = I_GU + T / 4;
        for (int it = gwp; it < NITEMS; it += NGW) {
            if (it < I_GU) tr_item(a.in[2], D, 2 * FF, W1GU, D, 0, a.in[1], FF, 0, it, scr, lane);
            else xb_rows4(a.in[0] + (size_t)(it - I_GU) * 4 * D, HB + (size_t)(it - I_GU) * 4 * D, SSQ0 + (size_t)(it - I_GU) * 4 * 16, lane);
        }
        SEAM(0);
    }
    if (IN(1)) {
        pg8::Gemm g{HB, W1GU, T, 2 * FF, D}; pg8::StaticOrder S; S.init(T, 2 * FF, G, bx);
        LAS float* rsl = (LAS float*)(lds + RSL_OFF); pg8::Unit u0{-1, 0}; S.next(0, u0);
        if (u0.pm >= 0) pg8::load_panel_rs(SSQ0, rsl, u0.pm); else __syncthreads();
        pg8::EpiSwiGLU E{ACT, SSQ0, FF, rsl, u0.pm};
        pg8::gemm_phase<pg8::EpiSwiGLU, pg8::StaticOrder, true, true>(lds, g, S, E);
        {
            constexpr int I_GU = (D / 64) * (2 * FF / 64), I_DN = (FF / 64) * (D / 64), I_IN = (D / 64) * (INW / 64), I_WA = (PW / 64) * (D / 64), I_WO = (D / 64) * (D / 64);
            constexpr int NIT = I_DN + I_WA + I_WO + I_IN + I_GU;
            const int rem = ((T / 256) * (2 * FF / 256)) % G, nidle = G - rem;
            if (bx >= rem) { LAS float* scr = (LAS float*)(lds + wave * 16384);
                for (int it = wave * nidle + (bx - rem); it < NIT; it += nidle * NWAVES) {
                    int r = it;
                    if (r < I_DN) { tr_item(a.in[3], FF, D, W1D, FF, 0, nullptr, 0, 0, r, scr, lane); continue; } r -= I_DN;
                    if (r < I_WA) { tr_item(a.in[9], PW, D, WBR, 1024, 512, nullptr, 0, 0, r, scr, lane); continue; } r -= I_WA;
                    if (r < I_WO) { tr_item(a.in[10], D, D, WOUT, D, 0, nullptr, 0, 0, r, scr, lane); continue; } r -= I_WO;
                    if (r < I_IN) { tr_item(a.in[5], D, INW, WIN, D, 0, a.in[4], 1024, 2048, r, scr, lane); continue; } r -= I_IN;
                    tr_item(a.in[12], D, 2 * FF, W2GU, D, 0, a.in[11], FF, 0, r, scr, lane); } }
        }
        SEAM(1);
    }
    if (IN(2)) {
        pg8::Gemm g{ACT, W1D, T, D, FF}; pg8::StaticOrder S; S.init(T, D, G, bx);
        pg8::EpiDown<false> E{nullptr, HB, HB, SSQ1, 0.5f};
        pg8::gemm_phase<pg8::EpiDown<false>, pg8::StaticOrder, false, true>(lds, g, S, E);
        SEAM(2);
    }
    if (IN(3)) {
        pg8::Gemm g{HB, WIN, T, INW, D}; pg8::StaticOrder S; S.init(T, INW, G, bx);
        LAS float* rsl = (LAS float*)(lds + RSL_OFF); pg8::Unit u0{-1, 0}; S.next(0, u0);
        if (u0.pm >= 0) pg8::load_panel_rs(SSQ1, rsl, u0.pm); else __syncthreads();
        pg8::EpiWin E{P4, GR, GS, SSQ1, rsl, u0.pm};
        pg8::gemm_phase<pg8::EpiWin, pg8::StaticOrder, true, true>(lds, g, S, E);
        SEAM(3);
    }
    if (IN(4)) {
#pragma nounroll
        for (int rep_ = 0; rep_ < 1 + PROBE_ATTN2; ++rep_)
        if (G == 256) {
            const int x = bx & 7, wq = (bx >> 3) * 8 + wave;
            sb::attn_wave2(8 * x + (wq >> 5), wq & 31, QO, KB, VB, OB, lane);
        } else for (int w = gwp; w < 2048; w += NGW) sb::attn_wave2(w >> 5, w & 31, QO, KB, VB, OB, lane);
#pragma nounroll
        for (int rep_ = 0; rep_ < 1 + PROBE_POOL2; ++rep_)
        pool_phase(XP, PO, gwp, NGW, lane);
        SEAM(4);
    }
    if (IN(5)) {
        pg8::Gemm g{PO, WBR, T, D, D}; pg8::StaticOrder S; S.init(T, D, G, bx);
        pg8::EpiBranchF E{MB, GR, GS};
        pg8::gemm_phase<pg8::EpiBranchF, pg8::StaticOrder, true, true>(lds, g, S, E);
        SEAM(5);
    }
    if (IN(6)) {
        pg8::Gemm g{MB, WOUT, T, D, D}; pg8::StaticOrder S; S.init(T, D, G, bx);
        pg8::EpiDown<false> E{nullptr, HB, HB2, SSQ2, 1.0f};
        pg8::gemm_phase<pg8::EpiDown<false>, pg8::StaticOrder, false, true>(lds, g, S, E);
        SEAM(6);
    }
    if (IN(7)) {
        pg8::Gemm g{HB2, W2GU, T, 2 * FF, D}; pg8::StaticOrder S; S.init(T, 2 * FF, G, bx);
        LAS float* rsl = (LAS float*)(lds + RSL_OFF); pg8::Unit u0{-1, 0}; S.next(0, u0);
        if (u0.pm >= 0) pg8::load_panel_rs(SSQ2, rsl, u0.pm); else __syncthreads();
        pg8::EpiSwiGLU E{ACT, SSQ2, FF, rsl, u0.pm};
        pg8::gemm_phase<pg8::EpiSwiGLU, pg8::StaticOrder, true, true>(lds, g, S, E);
        {
            constexpr int I_DN = (FF / 64) * (D / 64);
            const int rem = ((T / 256) * (2 * FF / 256)) % G, nidle = G - rem;
            if (bx >= rem) { LAS float* scr = (LAS float*)(lds + wave * 16384);
                for (int it = wave * nidle + (bx - rem); it < I_DN; it += nidle * NWAVES) tr_item(a.in[13], FF, D, W2D, FF, 0, nullptr, 0, 0, it, scr, lane); }
        }
        SEAM(7);
    }
    const bool fuse_final = (G == 256) && (lo <= 8) && (hi >= 10);
    if (IN(8)) {
        pg8::Gemm g{ACT, W2D, T, D, FF}; pg8::StaticOrder S; S.init(T, D, G, bx);
        if (fuse_final) {
            pg8::EpiDownFinal E{HB2, H, a.in[14], SSQ1, (unsigned*)ws + CW_CNT, 0.5f};
            pg8::gemm_phase<pg8::EpiDownFinal, pg8::StaticOrder, true, true>(lds, g, S, E);
        } else {
            pg8::EpiDownF32 E{HB2, H, 0.5f};
            pg8::gemm_phase<pg8::EpiDownF32, pg8::StaticOrder, true, true>(lds, g, S, E);
            SEAM(8);
        }
    }
    if (IN(9) && !fuse_final) {
        for (int r = gwp; r < T; r += NGW) rms_row_f32(H + (size_t)r * D, a.in[14], lane);
    }
#undef IN
#undef SEAM
}

#undef W1GU
#undef W1D
#undef WIN
#undef WBR
#undef WOUT
#undef W2GU
#undef W2D
#undef SSQ1
#undef SSQ2
#undef SSQ0
#undef HB
#undef ACT
#undef P4
#undef GR
#undef GS
#undef MB
#undef XP
#undef QO
#undef KB
#undef VB
#undef H
#undef OB
#undef PO
#undef HB2

extern "C" void kernel_launch(void* const* d_in, const int* in_sizes, int n_in, void* d_out, int out_size, void* d_ws, size_t ws_size, hipStream_t stream) {
    static int grid = 0;
    if (grid == 0) {
        if (n_in != 15 || in_sizes[0] != T * D || out_size != T * D || ws_size < WS_END) { fprintf(stderr, "kernel_launch: unexpected shapes (n_in %d, in0 %d, out %d, ws %zu); nothing launched\n", n_in, n_in > 0 ? in_sizes[0] : -1, out_size, ws_size); grid = -1; return; }
        int dev = 0, cus = 0, per_cu = 0;
        if (hipGetDevice(&dev) != hipSuccess || hipDeviceGetAttribute(&cus, hipDeviceAttributeMultiprocessorCount, dev) != hipSuccess) { grid = -1; return; }
        if (hipFuncSetAttribute((const void*)mega, hipFuncAttributeMaxDynamicSharedMemorySize, LDS_BYTES) != hipSuccess) { fprintf(stderr, "kernel_launch: hipFuncSetAttribute failed\n"); grid = -1; return; }
        if (hipOccupancyMaxActiveBlocksPerMultiprocessor(&per_cu, (const void*)mega, NWAVES * 64, LDS_BYTES) != hipSuccess || per_cu < 1) { fprintf(stderr, "kernel_launch: occupancy query says %d per CU; using 1\n", per_cu); per_cu = 1; }
        (void)hipGetLastError();
        grid = cus * per_cu;
        if (grid > 256 && grid % 8) grid -= grid % 8;
    }
    if (grid < 0) return;
    Args a{};
    for (int i = 0; i < 15; ++i) a.in[i] = (const float*)d_in[i];
    a.out = (float*)d_out; a.ws = (unsigned char*)d_ws;
#if DEBUG_MODE == 0
    if (hipMemsetAsync(d_ws, 0, CTL_ZERO_BYTES, stream) != hipSuccess) { fprintf(stderr, "kernel_launch: hipMemsetAsync failed\n"); return; }
    void* args[] = {&a};
    const int cut = PROBE_REPEAT >= 0 ? PROBE_REPEAT + 1 : (PROBE_SPLIT >= 0 ? PROBE_SPLIT + 1 : NPHASE);
    a.ph_lo = 0; a.ph_hi = cut; a.li = 0;
    hipError_t e = hipLaunchCooperativeKernel((const void*)mega, dim3(grid), dim3(NWAVES * 64), args, LDS_BYTES, stream);
    if (e == hipSuccess && cut < NPHASE) { a.ph_lo = PROBE_REPEAT >= 0 ? PROBE_REPEAT : cut; a.ph_hi = NPHASE; a.li = 1;
        e = hipLaunchCooperativeKernel((const void*)mega, dim3(grid), dim3(NWAVES * 64), args, LDS_BYTES, stream); }
    if (e != hipSuccess) fprintf(stderr, "kernel_launch: cooperative launch failed: %s (grid %d)\n", hipGetErrorString(e), grid);
#else
    for (int ph = 0; ph < NPHASE; ++ph) {
        a.ph_lo = ph; a.ph_hi = ph + 1;
        hipLaunchKernelGGL(mega, dim3(grid), dim3(NWAVES * 64), LDS_BYTES, stream, a);
    }
#endif
}
```

```cpp
#include <hip/hip_runtime.h>
#include <hip/hip_cooperative_groups.h>
#include <cstdio>
#include <cstdint>
namespace cg = cooperative_groups;
#ifndef DEBUG_MODE
#define DEBUG_MODE 0
#endif
namespace pg8 {
#define PG8_LAS __attribute__((address_space(3)))
typedef unsigned short bf16_t;
typedef short bf16x8 __attribute__((ext_vector_type(8)));
typedef float f32x4 __attribute__((ext_vector_type(4)));
typedef unsigned u32x4 __attribute__((ext_vector_type(4)));
constexpr int BM = 256, BK = 64, HALF = 128, HTB = HALF * BK * 2  , STAGE_BYTES = 8 * HTB, NXCD = 8, WGM = 8;

__host__ __device__ __forceinline__ int lds_byte(int r, int c) { const int st = (r >> 4) * 2 + (c >> 5), rr = r & 15, cc = c & 31, ob = rr * 64 + cc * 2; return st * 1024 + (ob ^ (((ob >> 9) & 1) << 5)); }
__host__ __device__ __forceinline__ void stage_rc(int b, int& R, int& C) { const int st = b / 1024, sb = b % 1024, swz = sb ^ (((sb >> 9) & 1) << 5); R = (st >> 1) * 16 + swz / 64; C = (st & 1) * 32 + (swz % 64) / 2; }
__host__ __device__ __forceinline__ int perm32(int rho) { const int n = rho >> 4, i = rho & 15; return 8 * (i >> 2) + 4 * n + (i & 3); }

struct Unit { int pm, pn; };
struct Gemm { const bf16_t* A; const bf16_t* Bt; int M, N, K; };

struct StaticOrder {
    int nM, nN, nwg, G, c;
    __host__ __device__ void init(int M, int N, int G_, int c_) { nM = M / BM; nN = N / BM; nwg = nM * nN; G = G_; c = c_; }
    __host__ __device__ bool next(int i, Unit& u) const {
        const long L = (long)i * G + c; if (L >= nwg) return false;
        int wgid = (int)L; { const int q = nwg / NXCD, r = nwg % NXCD, xcd = wgid % NXCD, off = wgid / NXCD; wgid = (xcd < r ? xcd * (q + 1) : r * (q + 1) + (xcd - r) * q) + off; }
        const int nig = WGM * nN, gid = wgid / nig, fm = gid * WGM, gsz = (nM - fm) < WGM ? (nM - fm) : WGM;
        u.pm = fm + ((wgid % nig) % gsz); u.pn = (wgid % nig) / gsz; return true;
    }
    __device__ __forceinline__ void a_ready(const Unit&) const {}
    __device__ __forceinline__ void done(const Unit&) const {}
};

__device__ __forceinline__ unsigned cvt_pk_bf16(float lo, float hi) { unsigned r; asm volatile("v_cvt_pk_bf16_f32 %0, %1, %2" : "=v"(r) : "v"(lo), "v"(hi)); return r; }
typedef float f32x2 __attribute__((ext_vector_type(2)));
constexpr float RMS_EPS_F = 1e-6f, LOG2E_F = 1.4426950408889634f;
__device__ __forceinline__ float row_rs(const float* ssq, int row) {
    const f32x4* p = (const f32x4*)(ssq + (size_t)row * 16);
    const f32x4 a = p[0], b = p[1], c = p[2], d = p[3];
    const float s = (((a[0] + a[1]) + (a[2] + a[3])) + ((b[0] + b[1]) + (b[2] + b[3]))) + (((c[0] + c[1]) + (c[2] + c[3])) + ((d[0] + d[1]) + (d[2] + d[3])));
    return __builtin_amdgcn_rsqf(s * (1.0f / 1024.0f) + RMS_EPS_F);
}
__device__ __forceinline__ void rows_rs(const float* ssq, int row0, int fq, float (&rs)[2][4]) {
    f32x4 q[2][4];
#pragma unroll
    for (int ai = 0; ai < 2; ++ai)
#pragma unroll
        for (int m = 0; m < 4; ++m) q[ai][m] = *(const f32x4*)(ssq + (size_t)(row0 + ai * HALF + m * 16) * 16 + 4 * fq);
#pragma unroll
    for (int ai = 0; ai < 2; ++ai)
#pragma unroll
        for (int m = 0; m < 4; ++m) { float s = (q[ai][m][0] + q[ai][m][1]) + (q[ai][m][2] + q[ai][m][3]); s += __shfl_xor(s, 16); s += __shfl_xor(s, 32); rs[ai][m] = __builtin_amdgcn_rsqf(s * (1.0f / 1024.0f) + RMS_EPS_F); }
}
__device__ __forceinline__ void unit_rs(const float* ssq, const PG8_LAS float* rsl, int pm0, const Unit& u, int wr, int fr, int fq, float (&rs)[2][4]) {
    if (u.pm == pm0) {
#pragma unroll
        for (int ai = 0; ai < 2; ++ai)
#pragma unroll
            for (int m = 0; m < 4; ++m) rs[ai][m] = rsl[ai * HALF + wr * 64 + m * 16 + fr];
    } else rows_rs(ssq, u.pm * BM + wr * 64 + fr, fq, rs);
}
__device__ __forceinline__ void load_panel_rs(const float* ssq, PG8_LAS float* rsl, int pm0) {
    const int t = threadIdx.x;
    if (t < 256) rsl[t] = row_rs(ssq, pm0 * BM + t);
    __syncthreads();
}
__device__ __forceinline__ float sigmoid_f(float v) { return __builtin_amdgcn_rcpf(1.0f + __builtin_amdgcn_exp2f(-v * LOG2E_F)); }
__device__ __forceinline__ float bflo(unsigned w) { return __builtin_bit_cast(float, w << 16); }
__device__ __forceinline__ float bfhi(unsigned w) { return __builtin_bit_cast(float, w & 0xffff0000u); }

struct EpiSwiGLU {
    static constexpr bool PERM = true, AFTER_DRAIN = false, MID = false;
    bf16_t* O; const float* ssq; int ldo; const PG8_LAS float* rsl; int pm0;
    __device__ __forceinline__ void operator()(const f32x4 (&acc)[2][2][4][2], const Unit& u, int wr, int wc, int fr, int fq) const {
        const int row0 = u.pm * BM + wr * 64 + fr, col0 = u.pn * HALF + wc * 32 + 8 * fq;
        float rsv[2][4] = {{1.f, 1.f, 1.f, 1.f}, {1.f, 1.f, 1.f, 1.f}};
        if (ssq) unit_rs(ssq, rsl, pm0, u, wr, fr, fq, rsv);
#pragma unroll
        for (int ai = 0; ai < 2; ++ai)
#pragma unroll
            for (int m = 0; m < 4; ++m) {
                const int row = row0 + ai * HALF + m * 16;
                const float rs = rsv[ai][m];
                float o[8];
                const float nrl = -rs * LOG2E_F, rs2 = rs * rs;
#pragma unroll
                for (int n = 0; n < 2; ++n)
#pragma unroll
                    for (int h = 0; h < 2; ++h) {
                        const f32x2 g = {acc[ai][0][m][n][2 * h], acc[ai][0][m][n][2 * h + 1]}, uu = {acc[ai][1][m][n][2 * h], acc[ai][1][m][n][2 * h + 1]};
                        const f32x2 t = g * nrl; f32x2 ex; ex.x = __builtin_amdgcn_exp2f(t.x); ex.y = __builtin_amdgcn_exp2f(t.y);
                        const f32x2 d = ex + 1.0f; f32x2 r; r.x = __builtin_amdgcn_rcpf(d.x); r.y = __builtin_amdgcn_rcpf(d.y);
                        const f32x2 p = ((g * uu) * rs2) * r;
                        o[4 * n + 2 * h] = p.x; o[4 * n + 2 * h + 1] = p.y;
                    }
                u32x4 w; w.x = cvt_pk_bf16(o[0], o[1]); w.y = cvt_pk_bf16(o[2], o[3]); w.z = cvt_pk_bf16(o[4], o[5]); w.w = cvt_pk_bf16(o[6], o[7]);
                *(u32x4*)(O + (size_t)row * ldo + col0) = w;
            }
    }
};
template <bool F32BASE> struct EpiDown {
    static constexpr bool PERM = true, AFTER_DRAIN = false, MID = false;
    const float* basef; const bf16_t* baseh; bf16_t* HB; float* ssq; float alpha;
    __device__ __forceinline__ void operator()(const f32x4 (&acc)[2][2][4][2], const Unit& u, int wr, int wc, int fr, int fq) const {
        const int row0 = u.pm * BM + wr * 64 + fr, col0 = u.pn * BM + wc * 32 + 8 * fq;
        u32x4 bh[F32BASE ? 1 : 2][4][2];
        if constexpr (!F32BASE) {
#pragma unroll
            for (int ai = 0; ai < 2; ++ai)
#pragma unroll
                for (int m = 0; m < 4; ++m)
#pragma unroll
                    for (int bj = 0; bj < 2; ++bj) bh[ai][m][bj] = *(const u32x4*)(baseh + (size_t)(row0 + ai * HALF + m * 16) * 1024 + col0 + bj * HALF);
        }
#pragma unroll
        for (int ai = 0; ai < 2; ++ai) {
            f32x4 bf[F32BASE ? 4 : 1][2][2];
            if constexpr (F32BASE) {
#pragma unroll
                for (int m = 0; m < 4; ++m)
#pragma unroll
                    for (int bj = 0; bj < 2; ++bj) { const size_t off = (size_t)(row0 + ai * HALF + m * 16) * 1024 + col0 + bj * HALF;
                        bf[m][bj][0] = *(const f32x4*)(basef + off); bf[m][bj][1] = *(const f32x4*)(basef + off + 4); }
            }
#pragma unroll
            for (int m = 0; m < 4; ++m) {
                const int row = row0 + ai * HALF + m * 16; float s = 0.f;
#pragma unroll
                for (int bj = 0; bj < 2; ++bj) {
                    const size_t off = (size_t)row * 1024 + col0 + bj * HALF;
                    f32x4 b0, b1;
                    if constexpr (F32BASE) { b0 = bf[m][bj][0]; b1 = bf[m][bj][1]; }
                    else { const u32x4 bw = bh[ai][m][bj]; b0 = (f32x4){bflo(bw.x), bfhi(bw.x), bflo(bw.y), bfhi(bw.y)}; b1 = (f32x4){bflo(bw.z), bfhi(bw.z), bflo(bw.w), bfhi(bw.w)}; }
                    const f32x4 h0 = b0 + acc[ai][bj][m][0] * alpha, h1 = b1 + acc[ai][bj][m][1] * alpha;
                    u32x4 w; w.x = cvt_pk_bf16(h0[0], h0[1]); w.y = cvt_pk_bf16(h0[2], h0[3]); w.z = cvt_pk_bf16(h1[0], h1[1]); w.w = cvt_pk_bf16(h1[2], h1[3]); *(u32x4*)(HB + off) = w;
                    s += ((h0[0] * h0[0] + h0[1] * h0[1]) + (h0[2] * h0[2] + h0[3] * h0[3])) + ((h1[0] * h1[0] + h1[1] * h1[1]) + (h1[2] * h1[2] + h1[3] * h1[3]));
                }
                s += __shfl_xor(s, 16); s += __shfl_xor(s, 32); if (fq == 0) ssq[(size_t)row * 16 + u.pn * 4 + wc] = s;
            }
        }
    }
};
struct EpiWin {
    static constexpr bool PERM = true, AFTER_DRAIN = false, MID = false;
    bf16_t* P4; bf16_t* GR; bf16_t* GS; const float* ssq; const PG8_LAS float* rsl; int pm0;
    __device__ __forceinline__ void operator()(const f32x4 (&acc)[2][2][4][2], const Unit& u, int wr, int wc, int fr, int fq) const {
        const int pn = u.pn; const bool gate = pn >= 8;
        const int row0 = u.pm * BM + wr * 64 + fr;
        float rsv[2][4]; unit_rs(ssq, rsl, pm0, u, wr, fr, fq, rsv);
        if (!gate) {
            bf16_t* basep = P4 + (size_t)(pn >> 1) * ((size_t)16384 * 512);
            const float qs = ((pn >> 1) == 1) ? 0.125f * LOG2E_F : 1.0f;
            const int col0 = (pn & 1) * 256 + wc * 32 + 8 * fq;
#pragma unroll
            for (int ai = 0; ai < 2; ++ai)
#pragma unroll
                for (int m = 0; m < 4; ++m) {
                    const int row = row0 + ai * HALF + m * 16;
                    const float rs = rsv[ai][m] * qs;
#pragma unroll
                    for (int bj = 0; bj < 2; ++bj) {
                        const f32x4 v0 = acc[ai][bj][m][0] * rs, v1 = acc[ai][bj][m][1] * rs;
                        u32x4 w; w.x = cvt_pk_bf16(v0[0], v0[1]); w.y = cvt_pk_bf16(v0[2], v0[3]); w.z = cvt_pk_bf16(v1[0], v1[1]); w.w = cvt_pk_bf16(v1[2], v1[3]);
                        if ((pn >> 1) == 3) {
                            const int c = col0 + bj * HALF, hh = c >> 6, d0 = c & 63, bb = row >> 11, tt = row & 2047;
                            bf16_t* vt = basep + ((size_t)((bb * 8 + hh) * 64 + d0)) * 2048 + tt;
                            vt[0 * 2048] = (bf16_t)(w.x & 0xffffu); vt[1 * 2048] = (bf16_t)(w.x >> 16); vt[2 * 2048] = (bf16_t)(w.y & 0xffffu); vt[3 * 2048] = (bf16_t)(w.y >> 16);
                            vt[4 * 2048] = (bf16_t)(w.z & 0xffffu); vt[5 * 2048] = (bf16_t)(w.z >> 16); vt[6 * 2048] = (bf16_t)(w.w & 0xffffu); vt[7 * 2048] = (bf16_t)(w.w >> 16);
                        } else *(u32x4*)(basep + (size_t)row * 512 + col0 + bj * HALF) = w;
                    }
                }
        } else {
            const int col0 = (pn - 8) * HALF + wc * 32 + 8 * fq;
#pragma unroll
            for (int ai = 0; ai < 2; ++ai)
#pragma unroll
                for (int m = 0; m < 4; ++m) {
                    const int row = row0 + ai * HALF + m * 16;
                    const float rs = rsv[ai][m];
                    float r8[8], s8[8];
#pragma unroll
                    for (int n = 0; n < 2; ++n)
#pragma unroll
                        for (int e = 0; e < 4; ++e) { const float ea = __builtin_amdgcn_exp2f(acc[ai][0][m][n][e] * (-rs * LOG2E_F)), eb = __builtin_fminf(__builtin_amdgcn_exp2f(acc[ai][1][m][n][e] * (-rs * LOG2E_F)), 1e18f);
                            const float opb = 1.0f + eb;
                            s8[4 * n + e] = __builtin_amdgcn_rcpf(opb); r8[4 * n + e] = opb * __builtin_amdgcn_rcpf(1.0f + ea); }
                    u32x4 w; w.x = cvt_pk_bf16(r8[0], r8[1]); w.y = cvt_pk_bf16(r8[2], r8[3]); w.z = cvt_pk_bf16(r8[4], r8[5]); w.w = cvt_pk_bf16(r8[6], r8[7]);
                    *(u32x4*)(GR + (size_t)row * 1024 + col0) = w;
                    w.x = cvt_pk_bf16(s8[0], s8[1]); w.y = cvt_pk_bf16(s8[2], s8[3]); w.z = cvt_pk_bf16(s8[4], s8[5]); w.w = cvt_pk_bf16(s8[6], s8[7]);
                    *(u32x4*)(GS + (size_t)row * 1024 + col0) = w;
                }
        }
    }
};
struct EpiBranchF {
    static constexpr bool PERM = true, AFTER_DRAIN = false, MID = true;
    bf16_t* Mb; const bf16_t* GR; const bf16_t* GS;
    __device__ __forceinline__ void mid(f32x4 (&acc)[2][2][4][2], const Unit& u, int wr, int wc, int fr, int fq) const {
        int row0 = u.pm * BM + wr * 64 + fr; const int col0 = u.pn * BM + wc * 32 + 8 * fq;
        asm volatile("" : "+v"(row0));
#pragma unroll
        for (int ai = 0; ai < 2; ++ai) {
            u32x4 gw[4][2];
#pragma unroll
            for (int m = 0; m < 4; ++m)
#pragma unroll
                for (int bj = 0; bj < 2; ++bj) gw[m][bj] = *(const u32x4*)(GR + (size_t)(row0 + ai * HALF + m * 16) * 1024 + col0 + bj * HALF);
#pragma unroll
            for (int m = 0; m < 4; ++m)
#pragma unroll
                for (int bj = 0; bj < 2; ++bj) { const u32x4 w = gw[m][bj]; f32x4& v0 = acc[ai][bj][m][0]; f32x4& v1 = acc[ai][bj][m][1];
                    v0[0] *= bflo(w.x); v0[1] *= bfhi(w.x); v0[2] *= bflo(w.y); v0[3] *= bfhi(w.y); v1[0] *= bflo(w.z); v1[1] *= bfhi(w.z); v1[2] *= bflo(w.w); v1[3] *= bfhi(w.w); }
            asm volatile("" ::: "memory");
        }
    }
    __device__ __forceinline__ void operator()(const f32x4 (&acc)[2][2][4][2], const Unit& u, int wr, int wc, int fr, int fq) const {
        const int row0 = u.pm * BM + wr * 64 + fr, col0 = u.pn * BM + wc * 32 + 8 * fq;
        u32x4 gwv[2][4][2];
#pragma unroll
        for (int ai = 0; ai < 2; ++ai)
#pragma unroll
            for (int m = 0; m < 4; ++m)
#pragma unroll
                for (int bj = 0; bj < 2; ++bj) gwv[ai][m][bj] = *(const u32x4*)(GS + (size_t)(row0 + ai * HALF + m * 16) * 1024 + col0 + bj * HALF);
#pragma unroll
        for (int ai = 0; ai < 2; ++ai)
#pragma unroll
            for (int m = 0; m < 4; ++m)
#pragma unroll
                for (int bj = 0; bj < 2; ++bj) {
                    const size_t off = (size_t)(row0 + ai * HALF + m * 16) * 1024 + col0 + bj * HALF;
                    const u32x4 gw = gwv[ai][m][bj];
                    f32x4 v0 = acc[ai][bj][m][0], v1 = acc[ai][bj][m][1];
                    v0[0] *= bflo(gw.x); v0[1] *= bfhi(gw.x); v0[2] *= bflo(gw.y); v0[3] *= bfhi(gw.y); v1[0] *= bflo(gw.z); v1[1] *= bfhi(gw.z); v1[2] *= bflo(gw.w); v1[3] *= bfhi(gw.w);
                    u32x4 w; w.x = cvt_pk_bf16(v0[0], v0[1]); w.y = cvt_pk_bf16(v0[2], v0[3]); w.z = cvt_pk_bf16(v1[0], v1[1]); w.w = cvt_pk_bf16(v1[2], v1[3]);
                    *(u32x4*)(Mb + off) = w;
                }
    }
};
struct EpiDownFinal {
    static constexpr bool PERM = true, AFTER_DRAIN = true, MID = false;
    const bf16_t* base; float* out; const float* gain; float* xbuf; unsigned* cnt; float alpha;
    __device__ __forceinline__ void fused(f32x4 (&acc)[2][2][4][2], const Unit& u, int wr, int wc, int fr, int fq, PG8_LAS unsigned char* lds, int wid, int lane) const {
        PG8_LAS float* P = (PG8_LAS float*)lds;
        PG8_LAS float* S = (PG8_LAS float*)(lds + 4096);
        const int row0 = u.pm * BM + wr * 64 + fr, col0 = u.pn * BM + wc * 32 + 8 * fq;
        u32x4 bwv[2][4][2];
#pragma unroll
        for (int ai = 0; ai < 2; ++ai)
#pragma unroll
            for (int m = 0; m < 4; ++m)
#pragma unroll
                for (int bj = 0; bj < 2; ++bj) bwv[ai][m][bj] = *(const u32x4*)(base + (size_t)(row0 + ai * HALF + m * 16) * 1024 + col0 + bj * HALF);
#pragma unroll
        for (int ai = 0; ai < 2; ++ai)
#pragma unroll
            for (int m = 0; m < 4; ++m) {
                float s = 0.f;
#pragma unroll
                for (int bj = 0; bj < 2; ++bj) {
                    const u32x4 bw = bwv[ai][m][bj];
                    const f32x4 b0 = (f32x4){bflo(bw.x), bfhi(bw.x), bflo(bw.y), bfhi(bw.y)}, b1 = (f32x4){bflo(bw.z), bfhi(bw.z), bflo(bw.w), bfhi(bw.w)};
                    const f32x4 h0 = b0 + acc[ai][bj][m][0] * alpha, h1 = b1 + acc[ai][bj][m][1] * alpha;
                    acc[ai][bj][m][0] = h0; acc[ai][bj][m][1] = h1;
                    s += ((h0[0] * h0[0] + h0[1] * h0[1]) + (h0[2] * h0[2] + h0[3] * h0[3])) + ((h1[0] * h1[0] + h1[1] * h1[1]) + (h1[2] * h1[2] + h1[3] * h1[3]));
                }
                s += __shfl_xor(s, 16); s += __shfl_xor(s, 32);
                if (fq == 0) P[(ai * HALF + wr * 64 + m * 16 + fr) * 4 + wc] = s;
            }
        asm volatile("s_waitcnt lgkmcnt(0)" ::: "memory"); __builtin_amdgcn_s_barrier(); asm volatile("" ::: "memory");
        const int row = wid * 32 + (lane & 31);
        if (lane < 32) { const float t = (P[row * 4 + 0] + P[row * 4 + 1]) + (P[row * 4 + 2] + P[row * 4 + 3]);
            __hip_atomic_store(xbuf + (size_t)(u.pm * BM + row) * 4 + u.pn, t, __ATOMIC_RELAXED, __HIP_MEMORY_SCOPE_AGENT); }
        asm volatile("s_waitcnt vmcnt(0)" ::: "memory");
        if (lane == 0) __hip_atomic_fetch_add(cnt + 64 * u.pm, 1u, __ATOMIC_RELAXED, __HIP_MEMORY_SCOPE_AGENT);
        if (wid == 0) {
            unsigned sp = 0;
            while ((unsigned)__builtin_amdgcn_readfirstlane(__hip_atomic_load(cnt + 64 * u.pm, __ATOMIC_RELAXED, __HIP_MEMORY_SCOPE_AGENT)) < 32u) { __builtin_amdgcn_s_sleep(2); if (++sp > (1u << 20)) break; }
            __builtin_amdgcn_fence(__ATOMIC_ACQUIRE, "agent");
        }
        asm volatile("s_waitcnt vmcnt(0) lgkmcnt(0)" ::: "memory"); __builtin_amdgcn_s_barrier(); asm volatile("" ::: "memory");
        if (lane < 32) { const float* slot = xbuf + (size_t)(u.pm * BM + row) * 4; float t = 0.f;
#pragma unroll
            for (int k = 0; k < 4; ++k) t += __hip_atomic_load(slot + k, __ATOMIC_RELAXED, __HIP_MEMORY_SCOPE_AGENT);
            S[row] = __builtin_amdgcn_rsqf(t * (1.0f / 1024.0f) + RMS_EPS_F); }
        asm volatile("s_waitcnt lgkmcnt(0)" ::: "memory"); __builtin_amdgcn_s_barrier(); asm volatile("" ::: "memory");
#pragma unroll
        for (int bj = 0; bj < 2; ++bj) {
            const f32x4 g0 = *(const f32x4*)(gain + col0 + bj * HALF), g1 = *(const f32x4*)(gain + col0 + bj * HALF + 4);
#pragma unroll
            for (int ai = 0; ai < 2; ++ai)
#pragma unroll
                for (int m = 0; m < 4; ++m) {
                    const int r = ai * HALF + wr * 64 + m * 16 + fr; const float rs = S[r];
                    const size_t off = (size_t)(u.pm * BM + r) * 1024 + col0 + bj * HALF;
                    *(f32x4*)(out + off) = acc[ai][bj][m][0] * rs * g0; *(f32x4*)(out + off + 4) = acc[ai][bj][m][1] * rs * g1;
                }
        }
    }
};

struct EpiDownF32 {
    static constexpr bool PERM = true, AFTER_DRAIN = false, MID = false;
    const bf16_t* base; float* out; float alpha;
    __device__ __forceinline__ void operator()(const f32x4 (&acc)[2][2][4][2], const Unit& u, int wr, int wc, int fr, int fq) const {
        const int row0 = u.pm * BM + wr * 64 + fr, col0 = u.pn * BM + wc * 32 + 8 * fq;
#pragma unroll
        for (int ai = 0; ai < 2; ++ai)
#pragma unroll
            for (int m = 0; m < 4; ++m)
#pragma unroll
                for (int bj = 0; bj < 2; ++bj) {
                    const size_t off = (size_t)(row0 + ai * HALF + m * 16) * 1024 + col0 + bj * HALF;
                    const u32x4 bw = *(const u32x4*)(base + off);
                    const f32x4 b0 = (f32x4){bflo(bw.x), bfhi(bw.x), bflo(bw.y), bfhi(bw.y)}, b1 = (f32x4){bflo(bw.z), bfhi(bw.z), bflo(bw.w), bfhi(bw.w)};
                    *(f32x4*)(out + off) = b0 + acc[ai][bj][m][0] * alpha; *(f32x4*)(out + off + 4) = b1 + acc[ai][bj][m][1] * alpha;
                }
    }
};
template <class Epi, class Sched, bool ALIGN_EPI = false, bool SP2 = false>
__device__ __forceinline__ void gemm_phase(PG8_LAS unsigned char* lds, const Gemm g, const Sched& S, const Epi& E) {
    const int tid = threadIdx.x, wid = __builtin_amdgcn_readfirstlane(tid >> 6), lane = tid & 63, wr = wid >> 2, wc = wid & 3, fr = lane & 15, fq = lane >> 4;
    const int K = g.K, nt = K / BK;
    unsigned voffA[2], voffB[2];
#pragma unroll
    for (int i = 0; i < 2; ++i) { int R, C; stage_rc(tid * 16 + i * 8192, R, C); const int Rb = Epi::PERM ? ((R & ~31) + perm32(R & 31)) : R;
        voffA[i] = (unsigned)(R * K + C) * 2u; voffB[i] = (unsigned)(Rb * K + C) * 2u; }
    const size_t kstep = (size_t)(BK * 2);
    const size_t hstep = (size_t)HALF * K * 2;
    const size_t tstep = 2 * hstep;
    const unsigned ldsw = (unsigned)wid * 1024u;
    const int aoff = lds_byte(wr * 64 + fr, fq * 8), boff = lds_byte(wc * 32 + fr, fq * 8);
#define PG8_SA(b, h) (((b) * 2 + (h)) * HTB)
#define PG8_SB(b, h) ((4 + (b) * 2 + (h)) * HTB)
#define PG8_STAGE(bufoff, gbase, voff) do { _Pragma("unroll") for (int _i = 0; _i < 2; ++_i) \
        __builtin_amdgcn_global_load_lds((const unsigned*)((const char*)(gbase) + (voff)[_i]), (PG8_LAS unsigned*)(lds + (bufoff) + ldsw + _i * 8192), 16, 0, 0); } while (0)
#define PG8_LDA(dst, b, h) do { _Pragma("unroll") for (int m = 0; m < 4; ++m) _Pragma("unroll") for (int k = 0; k < 2; ++k) dst[m][k] = *(const PG8_LAS bf16x8*)(lds + PG8_SA(b, h) + aoff + m * 2048 + k * 1024); } while (0)
#define PG8_LDB(dst, b, h) do { _Pragma("unroll") for (int n = 0; n < 2; ++n) _Pragma("unroll") for (int k = 0; k < 2; ++k) dst[n][k] = *(const PG8_LAS bf16x8*)(lds + PG8_SB(b, h) + boff + n * 2048 + k * 1024); } while (0)
#define PG8_MMA(ai, bj, At, Bt) do { __builtin_amdgcn_s_setprio(1); _Pragma("unroll") for (int m = 0; m < 4; ++m) _Pragma("unroll") for (int n = 0; n < 2; ++n) _Pragma("unroll") for (int k = 0; k < 2; ++k) \
        acc[ai][bj][m][n] = __builtin_amdgcn_mfma_f32_16x16x32_bf16(Bt[n][k], At[m][k], acc[ai][bj][m][n], 0, 0, 0); __builtin_amdgcn_s_setprio(0); } while (0)
#define PG8_WAIT_V(n) asm volatile("s_waitcnt vmcnt(" #n ")" ::: "memory")
#define PG8_WAIT_L(n) asm volatile("s_waitcnt lgkmcnt(" #n ")" ::: "memory")
#define PG8_BAR __builtin_amdgcn_s_barrier()
#define PG8_SCHED __builtin_amdgcn_sched_barrier(0)
    Unit cur, nxt; int ui = 0;
    if (!S.next(0, cur)) return;
    f32x4 acc[2][2][4][2];
#pragma unroll
    for (int a = 0; a < 2; ++a)
#pragma unroll
        for (int b = 0; b < 2; ++b)
#pragma unroll
            for (int m = 0; m < 4; ++m)
#pragma unroll
                for (int n = 0; n < 2; ++n) acc[a][b][m][n] = (f32x4){0.f, 0.f, 0.f, 0.f};
    bf16x8 At[4][2], B0[2][2], B1[2][2];
    const char* cA = (const char*)g.A + (size_t)cur.pm * tstep; const char* cB = (const char*)g.Bt + (size_t)cur.pn * tstep;
    S.a_ready(cur);
    if constexpr (SP2) {
        PG8_STAGE(PG8_SB(0, 0), cB, voffB); PG8_STAGE(PG8_SB(0, 1), cB + hstep, voffB); PG8_STAGE(PG8_SA(0, 0), cA, voffA); PG8_STAGE(PG8_SA(0, 1), cA + hstep, voffA);
        if (wr == 1) PG8_BAR;
        PG8_WAIT_V(2); PG8_BAR;
        PG8_STAGE(PG8_SB(1, 0), cB + kstep, voffB); PG8_STAGE(PG8_SA(1, 0), cA + kstep, voffA); PG8_STAGE(PG8_SB(1, 1), cB + hstep + kstep, voffB);
        PG8_WAIT_V(6); PG8_BAR;
    } else {
        PG8_STAGE(PG8_SB(0, 0), cB, voffB); PG8_STAGE(PG8_SA(0, 0), cA, voffA); PG8_STAGE(PG8_SB(0, 1), cB + hstep, voffB); PG8_STAGE(PG8_SA(0, 1), cA + hstep, voffA);
        if (wr == 1) PG8_BAR;
        PG8_WAIT_V(4); PG8_BAR;
        PG8_STAGE(PG8_SB(1, 0), cB + kstep, voffB); PG8_STAGE(PG8_SA(1, 0), cA + kstep, voffA); PG8_STAGE(PG8_SB(1, 1), cB + hstep + kstep, voffB);
        PG8_WAIT_V(6); PG8_BAR;
    }
    for (;;) {
        const bool has_next = S.next(ui + 1, nxt);
        const char* nA = has_next ? (const char*)g.A + (size_t)nxt.pm * tstep : cA; const char* nB = has_next ? (const char*)g.Bt + (size_t)nxt.pn * tstep : cB;
        for (int t = 0; t < nt; t += 2) {
            if constexpr (Epi::MID) { if (t == (nt >> 1)) E.mid(acc, cur, wr, wc, fr, fq); }
            const bool last = (t == nt - 2);
            const char* a1 = cA + (size_t)(t + 1) * kstep;
            const char* a2 = last ? nA : cA + (size_t)(t + 2) * kstep; const char* b2 = last ? nB : cB + (size_t)(t + 2) * kstep;
            const char* a3 = a2 + kstep; const char* b3 = b2 + kstep;
            if (last && has_next) S.a_ready(nxt);
            if constexpr (SP2) {
            PG8_LDB(B0, 0, 0); PG8_LDB(B1, 0, 1); PG8_SCHED; PG8_LDA(At, 0, 0); PG8_STAGE(PG8_SA(1, 1), a1 + hstep, voffA);
            PG8_WAIT_V(8); PG8_WAIT_L(0); PG8_BAR; PG8_MMA(0, 0, At, B0); PG8_MMA(0, 1, At, B1); PG8_BAR; PG8_SCHED;
            PG8_LDA(At, 0, 1); PG8_STAGE(PG8_SB(0, 0), b2, voffB); PG8_STAGE(PG8_SB(0, 1), b2 + hstep, voffB); PG8_STAGE(PG8_SA(0, 0), a2, voffA);
            PG8_WAIT_V(8); PG8_WAIT_L(0); PG8_BAR; PG8_MMA(1, 0, At, B0); PG8_MMA(1, 1, At, B1); PG8_BAR; PG8_SCHED;
            PG8_LDB(B0, 1, 0); PG8_LDB(B1, 1, 1); PG8_SCHED; PG8_LDA(At, 1, 0); PG8_STAGE(PG8_SA(0, 1), a2 + hstep, voffA);
            PG8_WAIT_V(8); PG8_WAIT_L(0); PG8_BAR; PG8_MMA(0, 0, At, B0); PG8_MMA(0, 1, At, B1); PG8_BAR; PG8_SCHED;
            PG8_LDA(At, 1, 1); PG8_STAGE(PG8_SB(1, 0), b3, voffB); PG8_STAGE(PG8_SB(1, 1), b3 + hstep, voffB); PG8_STAGE(PG8_SA(1, 0), a3, voffA);
            PG8_WAIT_V(8); PG8_WAIT_L(0); PG8_BAR; PG8_MMA(1, 0, At, B0); PG8_MMA(1, 1, At, B1); PG8_BAR; PG8_SCHED;
            } else {
            PG8_LDB(B0, 0, 0); PG8_SCHED; PG8_LDA(At, 0, 0); PG8_STAGE(PG8_SA(1, 1), a1 + hstep, voffA);
            PG8_WAIT_L(8); PG8_BAR; PG8_WAIT_L(0); PG8_MMA(0, 0, At, B0); PG8_BAR; PG8_SCHED;
            PG8_LDB(B1, 0, 1); PG8_STAGE(PG8_SB(0, 0), b2, voffB);
            PG8_BAR; PG8_WAIT_L(0); PG8_MMA(0, 1, At, B1); PG8_BAR;
            PG8_LDA(At, 0, 1); PG8_STAGE(PG8_SA(0, 0), a2, voffA);
            PG8_BAR; PG8_WAIT_L(0); PG8_MMA(1, 0, At, B0); PG8_BAR; PG8_SCHED;
            PG8_STAGE(PG8_SB(0, 1), b2 + hstep, voffB);
            PG8_WAIT_V(6); PG8_BAR; PG8_MMA(1, 1, At, B1); PG8_BAR;
            PG8_LDB(B0, 1, 0); PG8_SCHED; PG8_LDA(At, 1, 0); PG8_STAGE(PG8_SA(0, 1), a2 + hstep, voffA);
            PG8_WAIT_L(8); PG8_BAR; PG8_WAIT_L(0); PG8_MMA(0, 0, At, B0); PG8_BAR; PG8_SCHED;
            PG8_LDB(B1, 1, 1); PG8_STAGE(PG8_SB(1, 0), b3, voffB);
            PG8_BAR; PG8_WAIT_L(0); PG8_MMA(0, 1, At, B1); PG8_BAR;
            PG8_LDA(At, 1, 1); PG8_STAGE(PG8_SA(1, 0), a3, voffA);
            PG8_BAR; PG8_WAIT_L(0); PG8_MMA(1, 0, At, B0); PG8_BAR; PG8_SCHED;
            PG8_STAGE(PG8_SB(1, 1), b3 + hstep, voffB);
            PG8_WAIT_V(6); PG8_BAR; PG8_MMA(1, 1, At, B1); PG8_BAR;
            }
        }
        if constexpr (ALIGN_EPI) { if (wr == 0) PG8_BAR; }
        if constexpr (!Epi::AFTER_DRAIN) { E(acc, cur, wr, wc, fr, fq); S.done(cur); }
        if (!has_next) break;
#pragma unroll
        for (int a = 0; a < 2; ++a)
#pragma unroll
            for (int b = 0; b < 2; ++b)
#pragma unroll
                for (int m = 0; m < 4; ++m)
#pragma unroll
                    for (int n = 0; n < 2; ++n) acc[a][b][m][n] = (f32x4){0.f, 0.f, 0.f, 0.f};
        cur = nxt; cA = nA; cB = nB; ++ui;
        if constexpr (ALIGN_EPI) { if (wr == 1) PG8_BAR; }
    }
    PG8_WAIT_V(0);
    if constexpr (!ALIGN_EPI) { if (wr == 0) PG8_BAR; }
    PG8_BAR;
    if constexpr (Epi::AFTER_DRAIN) { E.fused(acc, cur, wr, wc, fr, fq, lds, wid, lane); S.done(cur); }
#undef PG8_SA
#undef PG8_SB
#undef PG8_STAGE
#undef PG8_LDA
#undef PG8_LDB
#undef PG8_MMA
#undef PG8_WAIT_V
#undef PG8_WAIT_L
#undef PG8_BAR
#undef PG8_SCHED
}
}
#define LAS __attribute__((address_space(3)))
typedef unsigned short bf16;
typedef unsigned v4u __attribute__((ext_vector_type(4)));
typedef unsigned v2u __attribute__((ext_vector_type(2)));
typedef float f32x4 __attribute__((ext_vector_type(4)));
typedef float f32x16 __attribute__((ext_vector_type(16)));
typedef short bf16x8 __attribute__((ext_vector_type(8)));
constexpr int T = 16384, D = 1024, FF = 2816, SEQ = 2048, NHEAD = 8, PW = 512, INW = 4096;
constexpr float RMS_EPS = 1e-6f;
constexpr int NWAVES = 8, LDS_BYTES = 147456;
constexpr int NPHASE = 10;
constexpr int LDSCTL_OFF = 131072, MISC_OFF = LDSCTL_OFF + 320;
constexpr int RSL_OFF = LDSCTL_OFF + 1024;
constexpr int CW_BAR = 4096;
constexpr int CW_CNT = 12288;
constexpr size_t CTL_ZERO_BYTES = 65536;
#ifndef PROBE_REPEAT
#define PROBE_REPEAT -1
#endif
#ifndef PROBE_DOUBLE_SEAM
#define PROBE_DOUBLE_SEAM 0
#endif
#ifndef PROBE_ATTN2
#define PROBE_ATTN2 0
#endif
#ifndef PROBE_POOL2
#define PROBE_POOL2 0
#endif
#ifndef PROBE_NOEXIT
#define PROBE_NOEXIT 0
#endif
#ifndef PROBE_SPLIT
#define PROBE_SPLIT -1
#endif
#ifndef PHASE_MASK
#define PHASE_MASK 1023
#endif
constexpr size_t MiB = 1u << 20;
constexpr size_t WS_W1GU = 2 * MiB, WS_W1D = 13 * MiB, WS_WIN = 19 * MiB, WS_WCOMB = 27 * MiB, WS_WA = 28 * MiB, WS_WOUT = 29 * MiB, WS_W2GU = 31 * MiB, WS_W2D = 42 * MiB;
constexpr size_t WS_SSQ = 48 * MiB;
constexpr size_t WS_HB = 52 * MiB;
constexpr size_t WS_BIG = 84 * MiB;
constexpr size_t WS_P4 = WS_BIG, WS_G = WS_BIG + 64 * MiB, WS_MB = WS_BIG + 32 * MiB;
constexpr size_t WS_PO = WS_BIG + 128 * MiB;
constexpr size_t WS_END = WS_PO + 32 * MiB;
static_assert(WS_W2D + (size_t)D * FF * 2 <= WS_SSQ && WS_SSQ + 3 * MiB <= WS_HB && WS_HB + 32 * MiB <= WS_BIG && (size_t)T * FF * 2 <= 128 * MiB && WS_END <= 256 * MiB, "d_ws map");

__device__ __forceinline__ unsigned f2bf(float f) { unsigned u = __builtin_bit_cast(unsigned, f); return (u + 0x7fffu + ((u >> 16) & 1u)) >> 16; }
__device__ __forceinline__ unsigned pk2(float lo, float hi) { return pg8::cvt_pk_bf16(lo, hi); }
__device__ __forceinline__ float bflo(unsigned w) { return __builtin_bit_cast(float, w << 16); }
__device__ __forceinline__ float bfhi(unsigned w) { return __builtin_bit_cast(float, w & 0xffff0000u); }
__device__ __forceinline__ float wave_sum(float v) {
#pragma unroll
    for (int o = 1; o < 64; o <<= 1) v += __shfl_xor(v, o);
    return v;
}
#define LDS_WAIT() asm volatile("s_waitcnt lgkmcnt(0)" ::: "memory")

__device__ __forceinline__ void tr_item(const float* W, int K, int N, bf16* WT, int ldw, int koff, const float* ks, int il, int ib, int item, LAS float* scr, int lane) {
    const int nblk = N / 64, kb = item / nblk, nb = item % nblk, k0 = 64 * kb, n0 = 64 * nb;
    int drow = n0;
    if (il > 0 && n0 >= ib) { const int second = (n0 - ib) >= il ? 1 : 0, j = n0 - ib - second * il; drow = ib + 256 * (j / 128) + 128 * second + (j % 128); }
    float va[32], vb[32];
#pragma unroll
    for (int i = 0; i < 32; ++i) { const int kk = 2 * i + (lane >> 5); const float* p = W + (size_t)(k0 + kk) * N + n0 + (lane & 31); va[i] = p[0]; vb[i] = p[32]; }
    if (ks) {
#pragma unroll
        for (int i = 0; i < 32; ++i) { const float sc = ks[k0 + 2 * i + (lane >> 5)]; va[i] *= sc; vb[i] *= sc; }
    }
    const int c = lane & 7;
#pragma unroll
    for (int h = 0; h < 2; ++h) {
#pragma unroll
        for (int i = 0; i < 32; ++i) scr[(2 * i + (lane >> 5)) * 33 + (lane & 31)] = h ? vb[i] : va[i];
        LDS_WAIT(); asm volatile("" ::: "memory");
#pragma unroll
        for (int j = 0; j < 4; ++j) { const int n = (lane >> 3) + 8 * j; const LAS float* s = scr + (8 * c) * 33 + n;
            v4u o; o.x = pk2(s[0 * 33], s[1 * 33]); o.y = pk2(s[2 * 33], s[3 * 33]); o.z = pk2(s[4 * 33], s[5 * 33]); o.w = pk2(s[6 * 33], s[7 * 33]);
            *(v4u*)(WT + (size_t)(drow + 32 * h + n) * ldw + koff + k0 + 8 * c) = o; }
        LDS_WAIT(); asm volatile("" ::: "memory");
    }
}
__device__ __forceinline__ void comb_item(const float* wg, const float* psc, const float* wbp, bf16* WC, int item, int lane) {
    const int nb = item >> 6, kc = item & 63, n = nb * 64 + lane, k0 = kc * 8, g = k0 >> 7, c0 = k0 & 127;
    float acc[8];
#pragma unroll
    for (int i = 0; i < 8; ++i) acc[i] = 0.f;
    const float* wrow = wg + (size_t)(g * 128 + c0) * 128;
#pragma unroll 32
    for (int d = 0; d < 128; ++d) {
        const float wv = wbp[(size_t)(g * 128 + d) * 1024 + n] * psc[g * 128 + d];
#pragma unroll
        for (int i = 0; i < 8; ++i) acc[i] += wrow[i * 128 + d] * wv;
    }
    v4u o; o.x = pk2(acc[0], acc[1]); o.y = pk2(acc[2], acc[3]); o.z = pk2(acc[4], acc[5]); o.w = pk2(acc[6], acc[7]);
    *(v4u*)(WC + (size_t)n * 1024 + k0) = o;
}
__device__ __forceinline__ void comb_block(const float* wg, const float* psc, const float* wbp, bf16* WC, int blk, LAS unsigned char* lds, int wave, int lane, int tid) {
    const int kc = blk >> 2, nq = blk & 3, k0 = kc * 8, g = k0 >> 7, c0 = k0 & 127, d0 = 16 * wave;
    const float* wrow = wg + (size_t)(g * 128 + c0) * 128 + d0;
    const float* wb = wbp + (size_t)(g * 128 + d0) * 1024 + nq * 256 + 4 * lane;
    f32x4 wv[16];
#pragma unroll
    for (int dd = 0; dd < 16; ++dd) wv[dd] = *(const f32x4*)(wb + (size_t)dd * 1024);
    f32x4 acc[8];
#pragma unroll
    for (int i = 0; i < 8; ++i) acc[i] = (f32x4){0.f, 0.f, 0.f, 0.f};
#pragma unroll
    for (int dd = 0; dd < 16; ++dd) { const f32x4 v = wv[dd] * psc[g * 128 + d0 + dd];
#pragma unroll
        for (int i = 0; i < 8; ++i) acc[i] += v * wrow[i * 128 + dd]; }
    LAS f32x4* red = (LAS f32x4*)lds;
#pragma unroll
    for (int i = 0; i < 8; ++i) red[(wave * 8 + i) * 64 + lane] = acc[i];
    __syncthreads();
    const int nl = tid & 255, kh = tid >> 8; const LAS float* rf = (const LAS float*)lds;
    float o[4];
#pragma unroll
    for (int j = 0; j < 4; ++j) { float s = 0.f;
#pragma unroll
        for (int w = 0; w < 8; ++w) s += rf[(((w * 8 + 4 * kh + j) * 64 + (nl >> 2)) << 2) + (nl & 3)];
        o[j] = s; }
    v2u pk; pk.x = pk2(o[0], o[1]); pk.y = pk2(o[2], o[3]);
    *(v2u*)(WC + (size_t)(nq * 256 + nl) * 1024 + k0 + 4 * kh) = pk;
    __syncthreads();
}
__device__ __forceinline__ void rms_rows4_bf16(const float* x4, const float* gain, bf16* o4, int lane) {
    const f32x4* gr = (const f32x4*)gain + lane;
    f32x4 v[4][4]; float s[4];
#pragma unroll
    for (int r = 0; r < 4; ++r)
#pragma unroll
        for (int j = 0; j < 4; ++j) v[r][j] = ((const f32x4*)(x4 + (size_t)r * D) + lane)[64 * j];
#pragma unroll
    for (int r = 0; r < 4; ++r) { s[r] = 0.f;
#pragma unroll
        for (int j = 0; j < 4; ++j) s[r] += (v[r][j].x * v[r][j].x + v[r][j].y * v[r][j].y) + (v[r][j].z * v[r][j].z + v[r][j].w * v[r][j].w); }
#pragma unroll
    for (int r = 0; r < 4; ++r) {
        const float rs = 1.0f / sqrtf(wave_sum(s[r]) * (1.0f / D) + RMS_EPS);
        unsigned long long* o8 = (unsigned long long*)(o4 + (size_t)r * D) + lane;
#pragma unroll
        for (int j = 0; j < 4; ++j) { const f32x4 gv = gr[64 * j]; const f32x4 o = v[r][j] * rs * gv;
            o8[64 * j] = (unsigned long long)pk2(o.x, o.y) | ((unsigned long long)pk2(o.z, o.w) << 32); }
    }
}
__device__ __forceinline__ void xb_rows4(const float* x4, bf16* o4, float* ssq4, int lane) {
    f32x4 v[4][4]; float s[4];
#pragma unroll
    for (int r = 0; r < 4; ++r)
#pragma unroll
        for (int j = 0; j < 4; ++j) v[r][j] = ((const f32x4*)(x4 + (size_t)r * D) + lane)[64 * j];
#pragma unroll
    for (int r = 0; r < 4; ++r) { s[r] = 0.f;
#pragma unroll
        for (int j = 0; j < 4; ++j) s[r] += (v[r][j].x * v[r][j].x + v[r][j].y * v[r][j].y) + (v[r][j].z * v[r][j].z + v[r][j].w * v[r][j].w); }
#pragma unroll
    for (int r = 0; r < 4; ++r) {
        const float t = wave_sum(s[r]);
        unsigned long long* o8 = (unsigned long long*)(o4 + (size_t)r * D) + lane;
#pragma unroll
        for (int j = 0; j < 4; ++j) o8[64 * j] = (unsigned long long)pk2(v[r][j].x, v[r][j].y) | ((unsigned long long)pk2(v[r][j].z, v[r][j].w) << 32);
        if (lane < 16) ssq4[r * 16 + lane] = lane ? 0.f : t;
    }
}
__device__ __forceinline__ void rms_row_f32(float* xrow, const float* gain, int lane) {
    f32x4* xr = (f32x4*)xrow + lane; const f32x4* gr = (const f32x4*)gain + lane;
    f32x4 v[4]; float s = 0.f;
#pragma unroll
    for (int j = 0; j < 4; ++j) { v[j] = xr[64 * j]; s += (v[j].x * v[j].x + v[j].y * v[j].y) + (v[j].z * v[j].z + v[j].w * v[j].w); }
    const float rs = 1.0f / sqrtf(wave_sum(s) * (1.0f / D) + RMS_EPS);
#pragma unroll
    for (int j = 0; j < 4; ++j) { const f32x4 gv = gr[64 * j]; xr[64 * j] = v[j] * rs * gv; }
}

namespace sb {
__device__ __forceinline__ void attn_wave(int bh, int rb, const bf16* Qp, const bf16* Kp, const bf16* Vt, bf16* Op  , int lane) {
    const int r32 = lane & 31, hi = lane >> 5, b = bh >> 3, h = bh & 7;
    const size_t rowbase = (size_t)b * SEQ;
    const int tq = rb * 32 + r32;
    const int kap = 16 * ((r32 >> 2) & 1) + (r32 & 3) + 4 * (r32 >> 3);
    bf16x8 qr[4];
    { const bf16* qrow = Qp + (rowbase + tq) * 512 + h * 64 + hi * 8;
#pragma unroll
      for (int s = 0; s < 4; ++s) qr[s] = *(const bf16x8*)(qrow + s * 16); }
    const bf16* kbase = Kp + (rowbase + kap) * 512 + h * 64 + hi * 8;
    const bf16* vbase = Vt + ((size_t)bh * 64 + r32) * 2048 + 16 * hi;
    f32x16 o0, o1;
#pragma unroll
    for (int r = 0; r < 16; ++r) { o0[r] = 0.f; o1[r] = 0.f; }
    float R = 1.0f;
#define SB_LOAD(KF, VF, JB) do { const int jl_ = (JB) > 0 ? (JB) : 0; _Pragma("unroll") for (int s = 0; s < 4; ++s) { \
        KF[s] = *(const bf16x8*)(kbase + (size_t)(32 * jl_) * 512 + 16 * s); VF[s] = *(const bf16x8*)(vbase + (size_t)(s >> 1) * 32 * 2048 + 32 * jl_ + 8 * (s & 1)); } } while (0)
#define SB_BLOCK(KF, VF, JB, MASKED) do { \
        f32x16 c; _Pragma("unroll") for (int r = 0; r < 16; ++r) c[r] = 0.f; \
        _Pragma("unroll") for (int s = 0; s < 4; ++s) c = __builtin_amdgcn_mfma_f32_32x32x16_bf16(KF[s], qr[s], c, 0, 0, 0); \
        const int lim = tq - (32 * (JB) + 16 * hi);                                \
        float mm[16]; \
        _Pragma("unroll") for (int r = 0; r < 16; ++r) { const float e = __builtin_amdgcn_exp2f(c[r]); float m = __builtin_amdgcn_rcpf(1.0f + e); if (MASKED && r >= lim) m = 1.0f; mm[r] = m; } \
        const float Tp = (((mm[0] * mm[1]) * (mm[2] * mm[3])) * ((mm[4] * mm[5]) * (mm[6] * mm[7]))) * (((mm[8] * mm[9]) * (mm[10] * mm[11])) * ((mm[12] * mm[13]) * (mm[14] * mm[15]))); \
        const float To = __shfl_xor(Tp, 32); \
        float Rl = hi ? R : R * To;                                                \
        float av[16]; \
        _Pragma("unroll") for (int r = 15; r >= 0; --r) { const float Rn = Rl * mm[r]; av[r] = Rl - Rn; Rl = Rn; } \
        R = R * Tp * To; \
        v4u p0, p1; \
        p0.x = pg8::cvt_pk_bf16(av[0], av[1]); p0.y = pg8::cvt_pk_bf16(av[2], av[3]); p0.z = pg8::cvt_pk_bf16(av[4], av[5]); p0.w = pg8::cvt_pk_bf16(av[6], av[7]); \
        p1.x = pg8::cvt_pk_bf16(av[8], av[9]); p1.y = pg8::cvt_pk_bf16(av[10], av[11]); p1.z = pg8::cvt_pk_bf16(av[12], av[13]); p1.w = pg8::cvt_pk_bf16(av[14], av[15]); \
        const bf16x8 pb0 = __builtin_bit_cast(bf16x8, p0), pb1 = __builtin_bit_cast(bf16x8, p1); \
        o0 = __builtin_amdgcn_mfma_f32_32x32x16_bf16(VF[0], pb0, o0, 0, 0, 0); o0 = __builtin_amdgcn_mfma_f32_32x32x16_bf16(VF[1], pb1, o0, 0, 0, 0); \
        o1 = __builtin_amdgcn_mfma_f32_32x32x16_bf16(VF[2], pb0, o1, 0, 0, 0); o1 = __builtin_amdgcn_mfma_f32_32x32x16_bf16(VF[3], pb1, o1, 0, 0, 0); } while (0)
#define SB_DONE(JB) ((JB) == 0 || (!PROBE_NOEXIT && __builtin_amdgcn_ballot_w64(R != 0.0f) == 0ull))
    bf16x8 ka[4], va[4], kb2[4], vb2[4], kc[4], vc[4];
    SB_LOAD(ka, va, rb); SB_LOAD(kb2, vb2, rb - 1);
    SB_LOAD(kc, vc, rb - 2); SB_BLOCK(ka, va, rb, true);
    if (!SB_DONE(rb)) for (int jb = rb - 1;; jb -= 3) {
        SB_LOAD(ka, va, jb - 2);   SB_BLOCK(kb2, vb2, jb, false);    if (SB_DONE(jb)) break;
        SB_LOAD(kb2, vb2, jb - 3); SB_BLOCK(kc, vc, jb - 1, false);  if (SB_DONE(jb - 1)) break;
        SB_LOAD(kc, vc, jb - 4);   SB_BLOCK(ka, va, jb - 2, false);  if (SB_DONE(jb - 2)) break;
    }
#undef SB_LOAD
#undef SB_BLOCK
#undef SB_DONE
    bf16* orow = Op + (rowbase + tq) * 1024 + h * 64 + 4 * hi;
#pragma unroll
    for (int g4 = 0; g4 < 4; ++g4) {
        v2u w0; w0.x = pg8::cvt_pk_bf16(o0[4 * g4], o0[4 * g4 + 1]); w0.y = pg8::cvt_pk_bf16(o0[4 * g4 + 2], o0[4 * g4 + 3]); *(v2u*)(orow + 8 * g4) = w0;
        v2u w1; w1.x = pg8::cvt_pk_bf16(o1[4 * g4], o1[4 * g4 + 1]); w1.y = pg8::cvt_pk_bf16(o1[4 * g4 + 2], o1[4 * g4 + 3]); *(v2u*)(orow + 32 + 8 * g4) = w1;
    }
}
__device__ __forceinline__ void attn_wave2(int bh, int u, const bf16* Qp, const bf16* Kp, const bf16* Vt, bf16* Op  , int lane) {
    const int r32 = lane & 31, hi = lane >> 5, b = bh >> 3, h = bh & 7;
    const size_t rowbase = (size_t)b * SEQ;
    const int tqA = 64 * u + r32, tqB = tqA + 32;
    const int kap = 16 * ((r32 >> 2) & 1) + (r32 & 3) + 4 * (r32 >> 3);
    bf16x8 qa[4], qb[4];
    { const bf16* qrow = Qp + (rowbase + tqA) * 512 + h * 64 + hi * 8;
#pragma unroll
      for (int s = 0; s < 4; ++s) { qa[s] = *(const bf16x8*)(qrow + s * 16); qb[s] = *(const bf16x8*)(qrow + (size_t)32 * 512 + s * 16); } }
    const bf16* kbase = Kp + (rowbase + kap) * 512 + h * 64 + hi * 8;
    const bf16* vbase = Vt + ((size_t)bh * 64 + r32) * 2048 + 16 * hi;
    f32x16 oa0, oa1, ob0, ob1;
#pragma unroll
    for (int r = 0; r < 16; ++r) { oa0[r] = 0.f; oa1[r] = 0.f; ob0[r] = 0.f; ob1[r] = 0.f; }
    float RA = 1.0f, RB = 1.0f;
#define SB_LOAD(KF, VF, JB) do { const int jl_ = (JB) > 0 ? (JB) : 0; _Pragma("unroll") for (int s = 0; s < 4; ++s) { \
        KF[s] = *(const bf16x8*)(kbase + (size_t)(32 * jl_) * 512 + 16 * s); VF[s] = *(const bf16x8*)(vbase + (size_t)(s >> 1) * 32 * 2048 + 32 * jl_ + 8 * (s & 1)); } } while (0)
#define SB_CHAIN(QR, O0, O1, RR, TQ, KF, VF, JB) do { \
        f32x16 c; _Pragma("unroll") for (int r = 0; r < 16; ++r) c[r] = 0.f; \
        _Pragma("unroll") for (int s = 0; s < 4; ++s) c = __builtin_amdgcn_mfma_f32_32x32x16_bf16(KF[s], QR[s], c, 0, 0, 0); \
        const int lim = (TQ) - (32 * (JB) + 16 * hi); \
        float mm[16]; \
        _Pragma("unroll") for (int r = 0; r < 16; ++r) { const float e = __builtin_amdgcn_exp2f(c[r]); float m = __builtin_amdgcn_rcpf(1.0f + e); if (r >= lim) m = 1.0f; mm[r] = m; } \
        const float Tp = (((mm[0] * mm[1]) * (mm[2] * mm[3])) * ((mm[4] * mm[5]) * (mm[6] * mm[7]))) * (((mm[8] * mm[9]) * (mm[10] * mm[11])) * ((mm[12] * mm[13]) * (mm[14] * mm[15]))); \
        const float To = __shfl_xor(Tp, 32); \
        float Rl = hi ? RR : RR * To; \
        float av[16]; \
        _Pragma("unroll") for (int r = 15; r >= 0; --r) { const float Rn = Rl * mm[r]; av[r] = Rl - Rn; Rl = Rn; } \
        RR = RR * Tp * To; \
        v4u p0, p1; \
        p0.x = pg8::cvt_pk_bf16(av[0], av[1]); p0.y = pg8::cvt_pk_bf16(av[2], av[3]); p0.z = pg8::cvt_pk_bf16(av[4], av[5]); p0.w = pg8::cvt_pk_bf16(av[6], av[7]); \
        p1.x = pg8::cvt_pk_bf16(av[8], av[9]); p1.y = pg8::cvt_pk_bf16(av[10], av[11]); p1.z = pg8::cvt_pk_bf16(av[12], av[13]); p1.w = pg8::cvt_pk_bf16(av[14], av[15]); \
        const bf16x8 pb0 = __builtin_bit_cast(bf16x8, p0), pb1 = __builtin_bit_cast(bf16x8, p1); \
        O0 = __builtin_amdgcn_mfma_f32_32x32x16_bf16(VF[0], pb0, O0, 0, 0, 0); O0 = __builtin_amdgcn_mfma_f32_32x32x16_bf16(VF[1], pb1, O0, 0, 0, 0); \
        O1 = __builtin_amdgcn_mfma_f32_32x32x16_bf16(VF[2], pb0, O1, 0, 0, 0); O1 = __builtin_amdgcn_mfma_f32_32x32x16_bf16(VF[3], pb1, O1, 0, 0, 0); } while (0)
#define SB_STEP(KF, VF, JB) do { SB_CHAIN(qb, ob0, ob1, RB, tqB, KF, VF, JB); SB_CHAIN(qa, oa0, oa1, RA, tqA, KF, VF, JB); } while (0)
#define SB_DONE(JB) ((JB) == 0 || __builtin_amdgcn_ballot_w64(RA != 0.0f || RB != 0.0f) == 0ull)
    const int jt = 2 * u + 1;
    bf16x8 ka[4], va[4], kb2[4], vb2[4];
    SB_LOAD(ka, va, jt); SB_LOAD(kb2, vb2, jt - 1);
    SB_CHAIN(qb, ob0, ob1, RB, tqB, ka, va, jt);
    for (int jb = jt - 1;; jb -= 2) {
        SB_LOAD(ka, va, jb - 1);   SB_STEP(kb2, vb2, jb);    if (SB_DONE(jb)) break;
        SB_LOAD(kb2, vb2, jb - 2); SB_STEP(ka, va, jb - 1);  if (SB_DONE(jb - 1)) break;
    }
#undef SB_LOAD
#undef SB_CHAIN
#undef SB_STEP
#undef SB_DONE
    bf16* orow = Op + (rowbase + tqA) * 1024 + h * 64 + 4 * hi;
#pragma unroll
    for (int g4 = 0; g4 < 4; ++g4) {
        v2u w; w.x = pg8::cvt_pk_bf16(oa0[4 * g4], oa0[4 * g4 + 1]); w.y = pg8::cvt_pk_bf16(oa0[4 * g4 + 2], oa0[4 * g4 + 3]); *(v2u*)(orow + 8 * g4) = w;
        w.x = pg8::cvt_pk_bf16(oa1[4 * g4], oa1[4 * g4 + 1]); w.y = pg8::cvt_pk_bf16(oa1[4 * g4 + 2], oa1[4 * g4 + 3]); *(v2u*)(orow + 32 + 8 * g4) = w;
        w.x = pg8::cvt_pk_bf16(ob0[4 * g4], ob0[4 * g4 + 1]); w.y = pg8::cvt_pk_bf16(ob0[4 * g4 + 2], ob0[4 * g4 + 3]); *(v2u*)(orow + (size_t)32 * 1024 + 8 * g4) = w;
        w.x = pg8::cvt_pk_bf16(ob1[4 * g4], ob1[4 * g4 + 1]); w.y = pg8::cvt_pk_bf16(ob1[4 * g4 + 2], ob1[4 * g4 + 3]); *(v2u*)(orow + (size_t)32 * 1024 + 32 + 8 * g4) = w;
    }
}
}

template <int W> __device__ __forceinline__ void pool_run(const bf16* XP, bf16* PO, int t0, int ch8) {
    constexpr int RUN = 8;
    const int pos0 = t0 & (SEQ - 1); const bf16* p = XP + (size_t)t0 * 512 + ch8 * 8;
    v4u v[W - 1 + RUN];
#pragma unroll
    for (int i = 0; i < W - 1 + RUN; ++i) { const int rel = i - (W - 1), rc = (pos0 + rel >= 0) ? rel : -pos0; v[i] = *(const v4u*)(p + (long)rc * 512); }
#pragma unroll
    for (int i = 0; i < W - 1; ++i) { if (pos0 + (i - (W - 1)) < 0) v[i] = (v4u){0u, 0u, 0u, 0u}; }
    float s[8];
#pragma unroll
    for (int k = 0; k < 8; ++k) s[k] = 0.f;
#pragma unroll
    for (int i = 0; i < W - 1; ++i) { s[0] += bflo(v[i].x); s[1] += bfhi(v[i].x); s[2] += bflo(v[i].y); s[3] += bfhi(v[i].y); s[4] += bflo(v[i].z); s[5] += bfhi(v[i].z); s[6] += bflo(v[i].w); s[7] += bfhi(v[i].w); }
#pragma unroll
    for (int j = 0; j < RUN; ++j) {
        const v4u x0 = v[W - 1 + j], xo = v[j];
        s[0] += bflo(x0.x); s[1] += bfhi(x0.x); s[2] += bflo(x0.y); s[3] += bfhi(x0.y); s[4] += bflo(x0.z); s[5] += bfhi(x0.z); s[6] += bflo(x0.w); s[7] += bfhi(x0.w);
        const int cnt = (pos0 + j + 1 < W) ? pos0 + j + 1 : W; const float inv = 1.0f / (float)cnt;
        v4u o; o.x = pk2(s[0] * inv - bflo(x0.x), s[1] * inv - bfhi(x0.x)); o.y = pk2(s[2] * inv - bflo(x0.y), s[3] * inv - bfhi(x0.y));
        o.z = pk2(s[4] * inv - bflo(x0.z), s[5] * inv - bfhi(x0.z)); o.w = pk2(s[6] * inv - bflo(x0.w), s[7] * inv - bfhi(x0.w));
        *(v4u*)(PO + (size_t)(t0 + j) * 1024 + ch8 * 8) = o;
        s[0] -= bflo(xo.x); s[1] -= bfhi(xo.x); s[2] -= bflo(xo.y); s[3] -= bfhi(xo.y); s[4] -= bflo(xo.z); s[5] -= bfhi(xo.z); s[6] -= bflo(xo.w); s[7] -= bfhi(xo.w);
    }
}
__device__ __forceinline__ void pool_phase(const bf16* XP, bf16* PO, int gwp, int NGW, int lane) {
    for (int wi = gwp; wi < 4 * (T / 32); wi += NGW) {
        const int wq = wi % (T / 32), g = 3 - (wi / (T / 32) + wq) % 4, t0 = 32 * wq + 8 * (lane >> 4), ch8 = 16 * g + (lane & 15);
        if (g == 3) pool_run<16>(XP, PO, t0, ch8); else if (g == 2) pool_run<8>(XP, PO, t0, ch8); else if (g == 1) pool_run<4>(XP, PO, t0, ch8); else pool_run<2>(XP, PO, t0, ch8);
    }
}

#define XB_TMO      128
#define XB_XCNT(j)  (256  + 64 * (j))
#define XB_XSUB(j)  (1280 + 64 * (j))
#define XB_XGEN(j)  (2304 + 64 * (j))
#define XB_TOP      3328
#define XB_TOPGEN   3392
#define XCD_BAR_WORDS 3456
#define XB_SPIN_CAP (1u << 18)

__device__ __forceinline__ unsigned xb_ld(unsigned* p)              { return __hip_atomic_load(p, __ATOMIC_RELAXED, __HIP_MEMORY_SCOPE_AGENT); }
__device__ __forceinline__ unsigned xb_add(unsigned* p, unsigned v) { return __hip_atomic_fetch_add(p, v, __ATOMIC_RELAXED, __HIP_MEMORY_SCOPE_AGENT); }
__device__ __forceinline__ unsigned xb_xcc_id() { return (unsigned)__builtin_amdgcn_s_getreg((3 << 11) | 20) & 0xFu; }
#define XB_SPIN(cond, bar) do { unsigned _sp = 0; while (cond) { __builtin_amdgcn_s_sleep(1); \
    if ((++_sp & 255u) == 0u) { if (xb_ld(&(bar)[XB_TMO])) break; if (_sp > XB_SPIN_CAP) { atomicAdd(&(bar)[XB_TMO], 1u); break; } } } } while (0)

struct XcdBarrier {
    unsigned* bar; unsigned x;
    volatile LAS unsigned* st;
};

__device__ __forceinline__ XcdBarrier xcd_barrier_post(unsigned* bar, volatile LAS unsigned* st) {
    XcdBarrier b; b.bar = bar; b.x = xb_xcc_id(); b.st = st;
    if (threadIdx.x == 0) (void)xb_add(&bar[XB_XCNT(b.x)], 1u);
    return b;
}
__device__ __forceinline__ void xcd_barrier_complete(unsigned* bar, unsigned x, unsigned& nloc, unsigned& nx) {
    const unsigned G = gridDim.x * gridDim.y * gridDim.z;
    unsigned sum, cnt, mine, sp = 0u;
    for (;;) {
        sum = 0u; cnt = 0u; mine = 0u;
#pragma unroll
        for (unsigned j = 0; j < 16; ++j) { const unsigned c = xb_ld(&bar[XB_XCNT(j)]); sum += c; cnt += (c > 0u) ? 1u : 0u; mine = (j == x) ? c : mine; }
        if (sum == G) break;
        __builtin_amdgcn_s_sleep(1);
        if ((++sp & 255u) == 0u) { if (xb_ld(&bar[XB_TMO])) break; if (sp > XB_SPIN_CAP) { atomicAdd(&bar[XB_TMO], 1u); break; } }
    }
    nloc = mine > 0u ? mine : 1u; nx = cnt > 0u ? cnt : 1u;
}

__device__ __forceinline__ void xcd_barrier(const XcdBarrier& b) {
    asm volatile("s_waitcnt vmcnt(0)" ::: "memory");
    __syncthreads();
    if (threadIdx.x == 0) {
        unsigned* bar = b.bar;
        __builtin_amdgcn_s_waitcnt(0);
        unsigned nloc = b.st[0], nx = b.st[1];
        if (nloc == 0u) { xcd_barrier_complete(bar, b.x, nloc, nx); b.st[0] = nloc; b.st[1] = nx; }
        const unsigned old = xb_add(&bar[XB_XSUB(b.x)], 1u);
        const unsigned gen = old / nloc;
        if (old + 1u == (gen + 1u) * nloc) {
            __builtin_amdgcn_fence(__ATOMIC_RELEASE, "agent");
            asm volatile("s_waitcnt vmcnt(0)" ::: "memory");
            const unsigned og = xb_add(&bar[XB_TOP], 1u);
            const unsigned tg = og / nx;
            if (og + 1u == (tg + 1u) * nx) xb_add(&bar[XB_TOPGEN], 1u);
            else XB_SPIN(xb_ld(&bar[XB_TOPGEN]) == tg, bar);
            __builtin_amdgcn_fence(__ATOMIC_ACQUIRE, "agent");
            xb_add(&bar[XB_XGEN(b.x)], 1u);
            asm volatile("s_waitcnt vmcnt(0)" ::: "memory");
        } else {
            XB_SPIN(xb_ld(&bar[XB_XGEN(b.x)]) == gen, bar);
            __builtin_amdgcn_fence(__ATOMIC_ACQUIRE, "agent");
            asm volatile("s_waitcnt vmcnt(0)" ::: "memory");
        }
    }
    __syncthreads();
}

struct Args { const float* in[15]; float* out; unsigned char* ws; int ph_lo, ph_hi, li, pad; };
__global__ void __launch_bounds__(NWAVES * 64, 2) mega(Args a) {
    extern __shared__ __attribute__((aligned(16))) unsigned char lds_raw[];
    LAS unsigned char* lds = (LAS unsigned char*)lds_raw;
    const int tid = threadIdx.x, lane = tid & 63, wave = __builtin_amdgcn_readfirstlane(tid >> 6);
    const int G = gridDim.x, bx = blockIdx.x, vcu = (G % 8 == 0) ? (bx % 8) * (G / 8) + bx / 8 : bx;
    unsigned char* const ws = a.ws;
#define W1GU ((bf16*)(ws + WS_W1GU))
#define W1D ((bf16*)(ws + WS_W1D))
#define WIN ((bf16*)(ws + WS_WIN))
#define WBR ((bf16*)(ws + WS_WCOMB))
#define WOUT ((bf16*)(ws + WS_WOUT))
#define W2GU ((bf16*)(ws + WS_W2GU))
#define W2D ((bf16*)(ws + WS_W2D))
#define SSQ1 ((float*)(ws + WS_SSQ))
#define SSQ2 ((float*)(ws + WS_SSQ) + (size_t)T * 16)
#define SSQ0 ((float*)(ws + WS_SSQ) + (size_t)2 * T * 16)
#define HB ((bf16*)(ws + WS_HB))
#define ACT ((bf16*)(ws + WS_BIG))
#define P4 ((bf16*)(ws + WS_P4))
#define GR ((bf16*)(ws + WS_G))
#define GS ((bf16*)(ws + WS_G) + (size_t)T * 1024)
#define MB ((bf16*)(ws + WS_MB))
#define XP P4
#define QO (P4 + (size_t)T * 512)
#define KB (P4 + (size_t)2 * T * 512)
#define VB (P4 + (size_t)3 * T * 512)
#define H (a.out)
#define PO ((bf16*)(ws + WS_PO))
#define HB2 PO
#define OB (PO + 512)
    cg::grid_group grid = cg::this_grid();
    for (int u = tid; u < (LDS_BYTES - LDSCTL_OFF) / 4; u += NWAVES * 64) ((LAS unsigned*)(lds + LDSCTL_OFF))[u] = 0u;
    __syncthreads();
    const XcdBarrier bar = xcd_barrier_post((unsigned*)ws + CW_BAR + a.li * XCD_BAR_WORDS, (volatile LAS unsigned*)(lds + MISC_OFF) + 8);
    const int gwp = wave * G + vcu, NGW = G * NWAVES;

    const int lo = a.ph_lo, hi = a.ph_hi;
#define IN(k) ((PHASE_MASK >> (k)) & 1) && (lo <= (k) && (k) < hi)
#define SEAM(k) do { if ((k) + 1 < hi) { if (hi > NPHASE) grid.sync(); else { xcd_barrier(bar); if (PROBE_DOUBLE_SEAM) xcd_barrier(bar); } } } while (0)
    if (IN(0)) {
        LAS float* scr = (LAS float*)(lds + wave * 16384);
        for (int blk = bx; blk < 256; blk += G) comb_block(a.in[6], a.in[7], a.in[8], WBR, blk, lds, wave, lane, tid);
        constexpr int I_GU = (D / 64) * (2 * FF / 64), NITEMS = I_GU + T / 4;
        for (int it = gwp; it < NITEMS; it += NGW) {
            if (it < I_GU) tr_item(a.in[2], D, 2 * FF, W1GU, D, 0, a.in[1], FF, 0, it, scr, lane);
            else xb_rows4(a.in[0] + (size_t)(it - I_GU) * 4 * D, HB + (size_t)(it - I_GU) * 4 * D, SSQ0 + (size_t)(it - I_GU) * 4 * 16, lane);
        }
        SEAM(0);
    }
    if (IN(1)) {
        pg8::Gemm g{HB, W1GU, T, 2 * FF, D}; pg8::StaticOrder S; S.init(T, 2 * FF, G, bx);
        LAS float* rsl = (LAS float*)(lds + RSL_OFF); pg8::Unit u0{-1, 0}; S.next(0, u0);
        if (u0.pm >= 0) pg8::load_panel_rs(SSQ0, rsl, u0.pm); else __syncthreads();
        pg8::EpiSwiGLU E{ACT, SSQ0, FF, rsl, u0.pm};
        pg8::gemm_phase<pg8::EpiSwiGLU, pg8::StaticOrder, true, true>(lds, g, S, E);
        {
            constexpr int I_GU = (D / 64) * (2 * FF / 64), I_DN = (FF / 64) * (D / 64), I_IN = (D / 64) * (INW / 64), I_WA = (PW / 64) * (D / 64), I_WO = (D / 64) * (D / 64);
            constexpr int NIT = I_DN + I_WA + I_WO + I_IN + I_GU;
            const int rem = ((T / 256) * (2 * FF / 256)) % G, nidle = G - rem;
            if (bx >= rem) { LAS float* scr = (LAS float*)(lds + wave * 16384);
                for (int it = wave * nidle + (bx - rem); it < NIT; it += nidle * NWAVES) {
                    int r = it;
                    if (r < I_DN) { tr_item(a.in[3], FF, D, W1D, FF, 0, nullptr, 0, 0, r, scr, lane); continue; } r -= I_DN;
                    if (r < I_WA) { tr_item(a.in[9], PW, D, WBR, 1024, 512, nullptr, 0, 0, r, scr, lane); continue; } r -= I_WA;
                    if (r < I_WO) { tr_item(a.in[10], D, D, WOUT, D, 0, nullptr, 0, 0, r, scr, lane); continue; } r -= I_WO;
                    if (r < I_IN) { tr_item(a.in[5], D, INW, WIN, D, 0, a.in[4], 1024, 2048, r, scr, lane); continue; } r -= I_IN;
                    tr_item(a.in[12], D, 2 * FF, W2GU, D, 0, a.in[11], FF, 0, r, scr, lane); } }
        }
        SEAM(1);
    }
    if (IN(2)) {
        pg8::Gemm g{ACT, W1D, T, D, FF}; pg8::StaticOrder S; S.init(T, D, G, bx);
        pg8::EpiDown<false> E{nullptr, HB, HB, SSQ1, 0.5f};
        pg8::gemm_phase<pg8::EpiDown<false>, pg8::StaticOrder, true, true>(lds, g, S, E);
        SEAM(2);
    }
    if (IN(3)) {
        pg8::Gemm g{HB, WIN, T, INW, D}; pg8::StaticOrder S; S.init(T, INW, G, bx);
        LAS float* rsl = (LAS float*)(lds + RSL_OFF); pg8::Unit u0{-1, 0}; S.next(0, u0);
        if (u0.pm >= 0) pg8::load_panel_rs(SSQ1, rsl, u0.pm); else __syncthreads();
        pg8::EpiWin E{P4, GR, GS, SSQ1, rsl, u0.pm};
        pg8::gemm_phase<pg8::EpiWin, pg8::StaticOrder, true, true>(lds, g, S, E);
        SEAM(3);
    }
    if (IN(4)) {
#pragma nounroll
        for (int rep_ = 0; rep_ < 1 + PROBE_ATTN2; ++rep_)
        if (G == 256) {
            const int x = bx & 7, wq = (bx >> 3) * 8 + wave;
            sb::attn_wave2(8 * x + (wq >> 5), wq & 31, QO, KB, VB, OB, lane);
        } else for (int w = gwp; w < 2048; w += NGW) sb::attn_wave2(w >> 5, w & 31, QO, KB, VB, OB, lane);
#pragma nounroll
        for (int rep_ = 0; rep_ < 1 + PROBE_POOL2; ++rep_)
        pool_phase(XP, PO, gwp, NGW, lane);
        SEAM(4);
    }
    if (IN(5)) {
        pg8::Gemm g{PO, WBR, T, D, D}; pg8::StaticOrder S; S.init(T, D, G, bx);
        pg8::EpiBranchF E{MB, GR, GS};
        pg8::gemm_phase<pg8::EpiBranchF, pg8::StaticOrder, true, true>(lds, g, S, E);
        SEAM(5);
    }
    if (IN(6)) {
        pg8::Gemm g{MB, WOUT, T, D, D}; pg8::StaticOrder S; S.init(T, D, G, bx);
        pg8::EpiDown<false> E{nullptr, HB, HB2, SSQ2, 1.0f};
        pg8::gemm_phase<pg8::EpiDown<false>, pg8::StaticOrder, true, true>(lds, g, S, E);
        SEAM(6);
    }
    if (IN(7)) {
        pg8::Gemm g{HB2, W2GU, T, 2 * FF, D}; pg8::StaticOrder S; S.init(T, 2 * FF, G, bx);
        LAS float* rsl = (LAS float*)(lds + RSL_OFF); pg8::Unit u0{-1, 0}; S.next(0, u0);
        if (u0.pm >= 0) pg8::load_panel_rs(SSQ2, rsl, u0.pm); else __syncthreads();
        pg8::EpiSwiGLU E{ACT, SSQ2, FF, rsl, u0.pm};
        pg8::gemm_phase<pg8::EpiSwiGLU, pg8::StaticOrder, true, true>(lds, g, S, E);
        {
            constexpr int I_DN = (FF / 64) * (D / 64);
            const int rem = ((T / 256) * (2 * FF / 256)) % G, nidle = G - rem;
            if (bx >= rem) { LAS float* scr = (LAS float*)(lds + wave * 16384);
                for (int it = wave * nidle + (bx - rem); it < I_DN; it += nidle * NWAVES) tr_item(a.in[13], FF, D, W2D, FF, 0, nullptr, 0, 0, it, scr, lane); }
        }
        SEAM(7);
    }
    const bool fuse_final = (G == 256) && (lo <= 8) && (hi >= 10);
    if (IN(8)) {
        pg8::Gemm g{ACT, W2D, T, D, FF}; pg8::StaticOrder S; S.init(T, D, G, bx);
        if (fuse_final) {
            pg8::EpiDownFinal E{HB2, H, a.in[14], SSQ1, (unsigned*)ws + CW_CNT, 0.5f};
            pg8::gemm_phase<pg8::EpiDownFinal, pg8::StaticOrder, true, true>(lds, g, S, E);
        } else {
            pg8::EpiDownF32 E{HB2, H, 0.5f};
            pg8::gemm_phase<pg8::EpiDownF32, pg8::StaticOrder, true, true>(lds, g, S, E);
            SEAM(8);
        }
    }
    if (IN(9) && !fuse_final) {
        for (int r = gwp; r < T; r += NGW) rms_row_f32(H + (size_t)r * D, a.in[14], lane);
    }
#undef IN
#undef SEAM
}

#undef W1GU
#undef W1D
#undef WIN
#undef WBR
#undef WOUT
#undef W2GU
#undef W2D
#undef SSQ1
#undef SSQ2
#undef SSQ0
#undef HB
#undef ACT
#undef P4
#undef GR
#undef GS
#undef MB
#undef XP
#undef QO
#undef KB
#undef VB
#undef H
#undef OB
#undef PO
#undef HB2

extern "C" void kernel_launch(void* const* d_in, const int* in_sizes, int n_in, void* d_out, int out_size, void* d_ws, size_t ws_size, hipStream_t stream) {
    static int grid = 0;
    if (grid == 0) {
        if (n_in != 15 || in_sizes[0] != T * D || out_size != T * D || ws_size < WS_END) { fprintf(stderr, "kernel_launch: unexpected shapes (n_in %d, in0 %d, out %d, ws %zu); nothing launched\n", n_in, n_in > 0 ? in_sizes[0] : -1, out_size, ws_size); grid = -1; return; }
        int dev = 0, cus = 0, per_cu = 0;
        if (hipGetDevice(&dev) != hipSuccess || hipDeviceGetAttribute(&cus, hipDeviceAttributeMultiprocessorCount, dev) != hipSuccess) { grid = -1; return; }
        if (hipFuncSetAttribute((const void*)mega, hipFuncAttributeMaxDynamicSharedMemorySize, LDS_BYTES) != hipSuccess) { fprintf(stderr, "kernel_launch: hipFuncSetAttribute failed\n"); grid = -1; return; }
        if (hipOccupancyMaxActiveBlocksPerMultiprocessor(&per_cu, (const void*)mega, NWAVES * 64, LDS_BYTES) != hipSuccess || per_cu < 1) { fprintf(stderr, "kernel_launch: occupancy query says %d per CU; using 1\n", per_cu); per_cu = 1; }
        (void)hipGetLastError();
        grid = cus * per_cu;
        if (grid > 256 && grid % 8) grid -= grid % 8;
    }
    if (grid < 0) return;
    Args a{};
    for (int i = 0; i < 15; ++i) a.in[i] = (const float*)d_in[i];
    a.out = (float*)d_out; a.ws = (unsigned char*)d_ws;
#if DEBUG_MODE == 0
    if (hipMemsetAsync(d_ws, 0, CTL_ZERO_BYTES, stream) != hipSuccess) { fprintf(stderr, "kernel_launch: hipMemsetAsync failed\n"); return; }
    void* args[] = {&a};
    const int cut = PROBE_REPEAT >= 0 ? PROBE_REPEAT + 1 : (PROBE_SPLIT >= 0 ? PROBE_SPLIT + 1 : NPHASE);
    a.ph_lo = 0; a.ph_hi = cut; a.li = 0;
    hipError_t e = hipLaunchCooperativeKernel((const void*)mega, dim3(grid), dim3(NWAVES * 64), args, LDS_BYTES, stream);
    if (e == hipSuccess && cut < NPHASE) { a.ph_lo = PROBE_REPEAT >= 0 ? PROBE_REPEAT : cut; a.ph_hi = NPHASE; a.li = 1;
        e = hipLaunchCooperativeKernel((const void*)mega, dim3(grid), dim3(NWAVES * 64), args, LDS_BYTES, stream); }
    if (e != hipSuccess) fprintf(stderr, "kernel_launch: cooperative launch failed: %s (grid %d)\n", hipGetErrorString(e), grid);
#else
    for (int ph = 0; ph < NPHASE; ++ph) {
        a.ph_lo = ph; a.ph_hi = ph + 1;
        hipLaunchKernelGGL(mega, dim3(grid), dim3(NWAVES * 64), LDS_BYTES, stream, a);
    }
#endif
}
```
